# Optimizing an MI355X kernel written in HIP

```python
import math
import jax, jax.numpy as jnp
from jax import lax
import numpy as np

D_MODEL = 2048
BATCH = 8
SEQ = 2048
DEPTH = 1

CHUNK = 64
Q_BLOCK = 128
EPS = 1e-6
MIX_WIDTH = D_MODEL
DA_HEADS = 8
DA_V_DIM = (MIX_WIDTH // 2) // DA_HEADS
DA_QK_DIM = DA_V_DIM // 2
DA_WIDTH = DA_HEADS * DA_V_DIM
DA_QK_WIDTH = DA_HEADS * 2 * DA_QK_DIM
ML_HEADS = 4
ML_HEAD_DIM = (MIX_WIDTH // 2) // ML_HEADS
ML_WIDTH = ML_HEADS * ML_HEAD_DIM
CONV_K = 4
D_FF = 4 * D_MODEL
PLE_DIM = 256
SPLIT_SIZES = (DA_QK_WIDTH, DA_QK_WIDTH, DA_WIDTH,
               ML_WIDTH, ML_WIDTH, ML_WIDTH, ML_WIDTH, ML_HEADS, ML_HEADS,
               D_MODEL, D_MODEL)
IN_COLS = sum(SPLIT_SIZES)
NEG_INF = -1e30

kernel_name = 'hybrid_diffattn_mlstm_block'


def rmsnorm(x, g):
    xf = x.astype(jnp.float32)
    y = xf * lax.rsqrt(jnp.mean(xf * xf, axis=-1, keepdims=True) + EPS)
    return (y * g.astype(jnp.float32)).astype(x.dtype)


def diff_attention(q, k, v, lam_q1, lam_k1, lam_q2, lam_k2, sub_g, lambda_init):
    bsz, seq = q.shape[0], q.shape[1]
    qf = q.astype(jnp.float32).reshape(bsz, seq, DA_HEADS, 2, DA_QK_DIM) * (DA_QK_DIM ** -0.5)
    kf = k.astype(jnp.float32).reshape(bsz, seq, DA_HEADS, 2, DA_QK_DIM)
    vf = v.astype(jnp.float32).reshape(bsz, seq, DA_HEADS, DA_V_DIM)
    f32 = jnp.float32
    lam = (jnp.exp(jnp.sum(lam_q1.astype(f32) * lam_k1.astype(f32)))
           - jnp.exp(jnp.sum(lam_q2.astype(f32) * lam_k2.astype(f32))) + lambda_init)
    outs = []
    for blk in range(seq // Q_BLOCK):
        q0 = blk * Q_BLOCK
        k_end = q0 + Q_BLOCK
        s = jnp.einsum('bqhmd,bkhmd->bhmqk', qf[:, q0:k_end], kf[:, :k_end])
        mask = (np.arange(k_end)[None, :] // CHUNK) <= (np.arange(q0, k_end)[:, None] // CHUNK)
        a = jax.nn.softmax(jnp.where(mask, s, NEG_INF), axis=-1)
        w = a[:, :, 0] - lam * a[:, :, 1]
        outs.append(jnp.einsum('bhqk,bkhd->bqhd', w, vf[:, :k_end]))
    o = jnp.concatenate(outs, axis=1)
    o = rmsnorm(o, sub_g) * (1.0 - lambda_init)
    return o.reshape(bsz, seq, DA_WIDTH).astype(q.dtype)


def causal_conv_silu(x, w, b):
    seq = x.shape[1]
    xp = jnp.pad(x, ((0, 0), (CONV_K - 1, 0), (0, 0)))
    y = b + sum(xp[:, j:j + seq] * w[j] for j in range(CONV_K))
    return jax.nn.silu(y)


def _to_chunks(t):
    bsz, seq, h = t.shape[0], t.shape[1], t.shape[2]
    t = jnp.swapaxes(t, 1, 2).reshape(bsz, h, seq // CHUNK, CHUNK, *t.shape[3:])
    return jnp.moveaxis(t, 2, 0)


def mlstm_chunkwise(q, k, v, log_i, log_f):
    bsz, seq, nh, d = q.shape
    qc = _to_chunks(q * (d ** -0.5))
    kc = _to_chunks(k)
    vc = _to_chunks(v)
    ic = _to_chunks(log_i)
    bc = jnp.cumsum(_to_chunks(log_f), axis=-1)
    causal = np.tril(np.ones((CHUNK, CHUNK), dtype=bool))

    def step(carry, xs):
        c_prev, n_prev, m_prev = carry
        q_c, k_c, v_c, i_c, b_c = xs
        dlog = b_c[..., :, None] - b_c[..., None, :] + i_c[..., None, :]
        dlog = jnp.where(causal, dlog, NEG_INF)
        inter_log = b_c + m_prev[..., None]
        m_t = jnp.maximum(inter_log, jnp.max(dlog, axis=-1))
        dmat = jnp.exp(dlog - m_t[..., None])
        inter_w = jnp.exp(inter_log - m_t)
        s = jnp.einsum('bhld,bhsd->bhls', q_c, k_c) * dmat
        num = (jnp.einsum('bhls,bhsd->bhld', s, v_c)
               + inter_w[..., None] * jnp.einsum('bhld,bhde->bhle', q_c, c_prev))
        den = jnp.sum(s, axis=-1) + inter_w * jnp.einsum('bhld,bhd->bhl', q_c, n_prev)
        h_out = num / jnp.maximum(jnp.abs(den), jnp.exp(-m_t))[..., None]
        b_last = b_c[..., -1]
        upd_log = b_last[..., None] - b_c + i_c
        m_new = jnp.maximum(b_last + m_prev, jnp.max(upd_log, axis=-1))
        w_s = jnp.exp(upd_log - m_new[..., None])
        decay = jnp.exp(b_last + m_prev - m_new)
        c_new = decay[..., None, None] * c_prev + jnp.einsum('bhs,bhsd,bhse->bhde', w_s, k_c, v_c)
        n_new = decay[..., None] * n_prev + jnp.einsum('bhs,bhsd->bhd', w_s, k_c)
        return (c_new, n_new, m_new), h_out

    init = (jnp.zeros((bsz, nh, d, d), jnp.float32),
            jnp.zeros((bsz, nh, d), jnp.float32),
            jnp.zeros((bsz, nh), jnp.float32))
    _, hs = lax.scan(step, init, (qc, kc, vc, ic, bc))
    return jnp.transpose(hs, (1, 0, 3, 2, 4)).reshape(bsz, seq, nh, d)


def setup_inputs(seed: int = 0) -> dict:
    key = jax.random.key(seed)
    ks = jax.random.split(key, 24)
    f32 = jnp.float32

    def nrm(k, shape, scale):
        return jax.random.normal(k, shape, f32) * scale

    def gain(k, shape):
        return 1.0 + 0.05 * jax.random.normal(k, shape, f32)

    return {
        'x': nrm(ks[0], (BATCH, SEQ, D_MODEL), 1.0),
        'p': nrm(ks[1], (DEPTH, BATCH, SEQ, PLE_DIM), 1.0),
        'g_mix': gain(ks[2], (DEPTH, D_MODEL)),
        'w_in': nrm(ks[3], (DEPTH, D_MODEL, IN_COLS), D_MODEL ** -0.5),
        'conv_w': nrm(ks[4], (DEPTH, CONV_K, 2 * ML_WIDTH), CONV_K ** -0.5),
        'conv_b': nrm(ks[5], (DEPTH, 2 * ML_WIDTH), 0.02),
        'b_i': nrm(ks[6], (DEPTH, ML_HEADS), 0.1) - 1.0,
        'b_f': nrm(ks[7], (DEPTH, ML_HEADS), 0.5) + 3.0,
        'lam_q1': nrm(ks[8], (DEPTH, DA_QK_DIM), 0.1),
        'lam_k1': nrm(ks[9], (DEPTH, DA_QK_DIM), 0.1),
        'lam_q2': nrm(ks[10], (DEPTH, DA_QK_DIM), 0.1),
        'lam_k2': nrm(ks[11], (DEPTH, DA_QK_DIM), 0.1),
        'da_sub_g': gain(ks[12], (DEPTH, DA_V_DIM)),
        'ml_norm_g': gain(ks[13], (DEPTH, ML_WIDTH)),
        'w_pa': nrm(ks[14], (DEPTH, DA_WIDTH, D_MODEL), DA_WIDTH ** -0.5),
        'w_pb': nrm(ks[15], (DEPTH, ML_WIDTH, D_MODEL), ML_WIDTH ** -0.5),
        'w_o': nrm(ks[16], (DEPTH, D_MODEL, D_MODEL), D_MODEL ** -0.5),
        'g_mlp': gain(ks[17], (DEPTH, D_MODEL)),
        'w_up': nrm(ks[18], (DEPTH, D_MODEL, D_FF), D_MODEL ** -0.5),
        'w_down': nrm(ks[19], (DEPTH, D_FF, D_MODEL), D_FF ** -0.5),
        'g_ple': gain(ks[20], (DEPTH, D_MODEL)),
        'w_ple_gate': nrm(ks[21], (DEPTH, D_MODEL, D_MODEL), D_MODEL ** -0.5),
        'w_ple_proj': nrm(ks[22], (DEPTH, PLE_DIM, D_MODEL), PLE_DIM ** -0.5),
        'g_final': gain(ks[23], (D_MODEL,)),
    }


def reference(x, p, g_mix, w_in, conv_w, conv_b, b_i, b_f, lam_q1, lam_k1, lam_q2, lam_k2,
              da_sub_g, ml_norm_g, w_pa, w_pb, w_o, g_mlp, w_up, w_down, g_ple, w_ple_gate,
              w_ple_proj, g_final):
    bsz, seq, _ = x.shape
    f32 = jnp.float32
    split_at = np.cumsum(SPLIT_SIZES)[:-1].tolist()
    ml_shape = (bsz, seq, ML_HEADS, ML_HEAD_DIM)
    for i in range(DEPTH):
        lambda_init = 0.8 - 0.6 * math.exp(-0.3 * i)
        h = rmsnorm(x, g_mix[i])
        (a_q, a_k, a_v, m_q, m_k, m_v, m_o, m_i, m_f, gate_a, gate_b) = jnp.split(
            h @ w_in[i], split_at, axis=-1)
        y_a = diff_attention(a_q, a_k, a_v, lam_q1[i], lam_k1[i], lam_q2[i], lam_k2[i],
                             da_sub_g[i], lambda_init)
        qk = causal_conv_silu(jnp.concatenate([m_q, m_k], axis=-1), conv_w[i], conv_b[i])
        m_q, m_k = jnp.split(qk, 2, axis=-1)
        log_i = (m_i + b_i[i]).astype(f32)
        log_f = jax.nn.log_sigmoid((m_f + b_f[i]).astype(f32))
        hm = mlstm_chunkwise(m_q.astype(f32).reshape(ml_shape), m_k.astype(f32).reshape(ml_shape),
                             m_v.astype(f32).reshape(ml_shape), log_i, log_f)
        hm = rmsnorm(hm, ml_norm_g[i].reshape(ML_HEADS, ML_HEAD_DIM)).reshape(bsz, seq, ML_WIDTH)
        y_b = (jax.nn.sigmoid(m_o.astype(f32)) * hm).astype(x.dtype)
        merged = (jax.nn.sigmoid(gate_a) * (y_a @ w_pa[i])
                  + jax.nn.sigmoid(gate_b) * (y_b @ w_pb[i]))
        x = x + merged @ w_o[i]
        u = rmsnorm(x, g_mlp[i]) @ w_up[i]
        x = x + jnp.square(jax.nn.relu(u)) @ w_down[i]
        ple_gate = jax.nn.sigmoid(rmsnorm(x, g_ple[i]) @ w_ple_gate[i])
        x = x + ple_gate * (p[i] @ w_ple_proj[i])
    return rmsnorm(x, g_final)
```

```cpp
#include <hip/hip_runtime.h>
#include <hip/hip_cooperative_groups.h>
#include <cstdio>
#include <cstdint>
namespace cg = cooperative_groups;
namespace pg8 {
#define PG8_LAS __attribute__((address_space(3)))
typedef unsigned short bf16_t;
typedef short bf16x8 __attribute__((ext_vector_type(8)));
typedef float f32x4 __attribute__((ext_vector_type(4)));
typedef unsigned u32x4 __attribute__((ext_vector_type(4)));
constexpr int BM = 256, BK = 64, HALF = 128, HTB = HALF * BK * 2  , STAGE_BYTES = 8 * HTB, NXCD = 8, WGM = 8;

__host__ __device__ __forceinline__ int lds_byte(int r, int c) { const int st = (r >> 4) * 2 + (c >> 5), rr = r & 15, cc = c & 31, ob = rr * 64 + cc * 2; return st * 1024 + (ob ^ (((ob >> 9) & 1) << 5)); }
__host__ __device__ __forceinline__ void stage_rc(int b, int& R, int& C) { const int st = b / 1024, sb = b % 1024, swz = sb ^ (((sb >> 9) & 1) << 5); R = (st >> 1) * 16 + swz / 64; C = (st & 1) * 32 + (swz % 64) / 2; }
__host__ __device__ __forceinline__ int perm32(int rho) { const int n = rho >> 4, i = rho & 15; return 8 * (i >> 2) + 4 * n + (i & 3); }

struct Unit { int pm, pn; };
struct Gemm { const bf16_t* A; const bf16_t* Bt; int M, N, K; };

struct StaticOrder {
    int nM, nN, nwg, G, c;
    __host__ __device__ void init(int M, int N, int G_, int c_) { nM = M / BM; nN = N / BM; nwg = nM * nN; G = G_; c = c_; }
    __host__ __device__ bool next(int i, Unit& u) const {
        const long L = (long)i * G + c; if (L >= nwg) return false;
        int wgid = (int)L; { const int q = nwg / NXCD, r = nwg % NXCD, xcd = wgid % NXCD, off = wgid / NXCD; wgid = (xcd < r ? xcd * (q + 1) : r * (q + 1) + (xcd - r) * q) + off; }
        const int nig = WGM * nN, gid = wgid / nig, fm = gid * WGM, gsz = (nM - fm) < WGM ? (nM - fm) : WGM;
        u.pm = fm + ((wgid % nig) % gsz); u.pn = (wgid % nig) / gsz; return true;
    }
    __device__ __forceinline__ void a_ready(const Unit&) const {}
    __device__ __forceinline__ void done(const Unit&) const {}
};

typedef unsigned u32x2 __attribute__((ext_vector_type(2)));
typedef float f32x2v __attribute__((ext_vector_type(2)));
typedef __bf16 bf16x2v __attribute__((ext_vector_type(2)));
__device__ __forceinline__ unsigned pkbf(float lo, float hi) { f32x2v v = {lo, hi}; bf16x2v b = __builtin_convertvector(v, bf16x2v); return __builtin_bit_cast(unsigned, b); }
__device__ __forceinline__ float bflo(unsigned w) { return __uint_as_float(w << 16); }
__device__ __forceinline__ float bfhi(unsigned w) { return __uint_as_float(w & 0xffff0000u); }
__device__ __forceinline__ float sigm(float x) { return __builtin_amdgcn_rcpf(1.f + __builtin_amdgcn_exp2f(-1.4426950408889634f * x)); }
constexpr float RMS_EPS = 1e-6f;

struct EpiInProj {
    static constexpr bool PERM = true, AFTER_DRAIN = false;
    bf16_t* Qf; bf16_t* Kf; bf16_t* MISC; float qscale;
    __device__ __forceinline__ void operator()(const f32x4 (&acc)[2][2][4][2], const Unit& u, int wr, int wc, int fr, int fq) const {
        const int colt = u.pn * BM, row0 = u.pm * BM + wr * 64 + fr;
#pragma unroll
        for (int ai = 0; ai < 2; ++ai)
#pragma unroll
            for (int m = 0; m < 4; ++m) { const int row = row0 + ai * HALF + m * 16;
#pragma unroll
                for (int bj = 0; bj < 2; ++bj) { const int col = colt + bj * HALF + wc * 32 + 8 * fq;
                    f32x4 v0 = acc[ai][bj][m][0], v1 = acc[ai][bj][m][1]; bf16_t* dst;
                    if (colt < 2048) {
                        if (colt < 1024) { v0 = v0 * qscale; v1 = v1 * qscale; }
                        const int c = col & 1023, h = c >> 7, mp = (c >> 6) & 1, d = c & 63, d0 = d >> 4, hi = (d >> 3) & 1, b = row >> 11, s = row & 2047;
                        const size_t idx16 = (size_t)((((((b * 8 + h) * 2 + mp) * 64 + (s >> 5)) * 4 + d0) * 2 + hi)) * 32 + (s & 31);
                        dst = (colt < 1024 ? Qf : Kf) + idx16 * 8;
                    } else {
                        const int cc = col - 2048;
                        if (cc >= 2048) {
#pragma unroll
                            for (int i = 0; i < 4; ++i) { v0[i] = sigm(v0[i]); v1[i] = sigm(v1[i]); } }
                        dst = MISC + (size_t)row * 7168 + cc;
                    }
                    u32x4 w; w.x = pkbf(v0[0], v0[1]); w.y = pkbf(v0[2], v0[3]); w.z = pkbf(v1[0], v1[1]); w.w = pkbf(v1[2], v1[3]);
                    *(u32x4*)dst = w; } }
    }
};
struct EpiVT {
    static constexpr bool PERM = true, AFTER_DRAIN = false;
    bf16_t* VtF; bf16_t* MvT;
    __device__ __forceinline__ void operator()(const f32x4 (&acc)[2][2][4][2], const Unit& u, int wr, int wc, int fr, int fq) const {
        const int row0 = u.pm * BM + wr * 64 + fr;
#pragma unroll
        for (int ai = 0; ai < 2; ++ai)
#pragma unroll
            for (int m = 0; m < 4; ++m) { const int R = row0 + ai * HALF + m * 16;
#pragma unroll
                for (int bj = 0; bj < 2; ++bj) { const int tok0 = u.pn * BM + bj * HALF + wc * 32 + 8 * fq;
                    const f32x4 v0 = acc[ai][bj][m][0], v1 = acc[ai][bj][m][1];
                    if (u.pm < 4) {
                        const int h = R >> 7, e = R & 127, eb = e >> 5, e32 = e & 31, b = tok0 >> 11, s = tok0 & 2047, kt = s >> 5, g = (s & 31) >> 3, t = g >> 1, jb = 4 * (g & 1);
                        bf16_t* base = VtF + (size_t)(((((b * 8 + h) * 64 + kt) * 4 + eb) * 2 + t)) * 512 + e32 * 8 + jb;
                        u32x2 w0, w1; w0.x = pkbf(v0[0], v0[1]); w0.y = pkbf(v0[2], v0[3]); w1.x = pkbf(v1[0], v1[1]); w1.y = pkbf(v1[2], v1[3]);
                        *(u32x2*)base = w0; *(u32x2*)(base + 256) = w1;
                    } else {
                        u32x4 w; w.x = pkbf(v0[0], v0[1]); w.y = pkbf(v0[2], v0[3]); w.z = pkbf(v1[0], v1[1]); w.w = pkbf(v1[2], v1[3]);
                        *(u32x4*)(MvT + (size_t)(R - 1024) * 16384 + tok0) = w;
                    } } }
    }
};
struct EpiMerge {
    static constexpr bool PERM = true, AFTER_DRAIN = false;
    bf16_t* O; const bf16_t* G; int second;
    __device__ __forceinline__ void operator()(const f32x4 (&acc)[2][2][4][2], const Unit& u, int wr, int wc, int fr, int fq) const {
        const int row0 = u.pm * BM + wr * 64 + fr;
#pragma unroll
        for (int ai = 0; ai < 2; ++ai)
#pragma unroll
            for (int m = 0; m < 4; ++m) { const int row = row0 + ai * HALF + m * 16;
#pragma unroll
                for (int bj = 0; bj < 2; ++bj) { const int col = u.pn * BM + bj * HALF + wc * 32 + 8 * fq;
                    f32x4 v0 = acc[ai][bj][m][0], v1 = acc[ai][bj][m][1];
                    const u32x4 g = *(const u32x4*)(G + (size_t)row * 7168 + col);
                    v0[0] *= bflo(g.x); v0[1] *= bfhi(g.x); v0[2] *= bflo(g.y); v0[3] *= bfhi(g.y); v1[0] *= bflo(g.z); v1[1] *= bfhi(g.z); v1[2] *= bflo(g.w); v1[3] *= bfhi(g.w);
                    bf16_t* dst = O + (size_t)row * 2048 + col;
                    if (second) { const u32x4 p = *(const u32x4*)dst;
                        v0[0] += bflo(p.x); v0[1] += bfhi(p.x); v0[2] += bflo(p.y); v0[3] += bfhi(p.y); v1[0] += bflo(p.z); v1[1] += bfhi(p.z); v1[2] += bflo(p.w); v1[3] += bfhi(p.w); }
                    u32x4 w; w.x = pkbf(v0[0], v0[1]); w.y = pkbf(v0[2], v0[3]); w.z = pkbf(v1[0], v1[1]); w.w = pkbf(v1[2], v1[3]);
                    *(u32x4*)dst = w; } }
    }
};
struct EpiUp {
    static constexpr bool PERM = true, AFTER_DRAIN = false;
    bf16_t* O; const float* ssq;
    __device__ __forceinline__ void operator()(const f32x4 (&acc)[2][2][4][2], const Unit& u, int wr, int wc, int fr, int fq) const {
        const int row0 = u.pm * BM + wr * 64 + fr;
#pragma unroll
        for (int ai = 0; ai < 2; ++ai)
#pragma unroll
            for (int m = 0; m < 4; ++m) { const int row = row0 + ai * HALF + m * 16; const float rs = __builtin_amdgcn_rsqf(ssq[row] * (1.f / 2048.f) + RMS_EPS);
#pragma unroll
                for (int bj = 0; bj < 2; ++bj) { const int col = u.pn * BM + bj * HALF + wc * 32 + 8 * fq;
                    f32x4 v0 = acc[ai][bj][m][0] * rs, v1 = acc[ai][bj][m][1] * rs;
#pragma unroll
                    for (int i = 0; i < 4; ++i) { const float a = fmaxf(v0[i], 0.f), b = fmaxf(v1[i], 0.f); v0[i] = a * a; v1[i] = b * b; }
                    u32x4 w; w.x = pkbf(v0[0], v0[1]); w.y = pkbf(v0[2], v0[3]); w.z = pkbf(v1[0], v1[1]); w.w = pkbf(v1[2], v1[3]);
                    *(u32x4*)(O + (size_t)row * 8192 + col) = w; } }
    }
};
struct EpiGate {
    static constexpr bool PERM = true, AFTER_DRAIN = false;
    bf16_t* O; const float* ssq;
    __device__ __forceinline__ void operator()(const f32x4 (&acc)[2][2][4][2], const Unit& u, int wr, int wc, int fr, int fq) const {
        const int row0 = u.pm * BM + wr * 64 + fr;
#pragma unroll
        for (int ai = 0; ai < 2; ++ai)
#pragma unroll
            for (int m = 0; m < 4; ++m) { const int row = row0 + ai * HALF + m * 16; const float rs = __builtin_amdgcn_rsqf(ssq[row] * (1.f / 2048.f) + RMS_EPS);
#pragma unroll
                for (int bj = 0; bj < 2; ++bj) { const int col = u.pn * BM + bj * HALF + wc * 32 + 8 * fq;
                    f32x4 v0 = acc[ai][bj][m][0] * rs, v1 = acc[ai][bj][m][1] * rs;
#pragma unroll
                    for (int i = 0; i < 4; ++i) { v0[i] = sigm(v0[i]); v1[i] = sigm(v1[i]); }
                    u32x4 w; w.x = pkbf(v0[0], v0[1]); w.y = pkbf(v0[2], v0[3]); w.z = pkbf(v1[0], v1[1]); w.w = pkbf(v1[2], v1[3]);
                    *(u32x4*)(O + (size_t)row * 2048 + col) = w; } }
    }
};

struct EpiResB {
    static constexpr bool PERM = true, AFTER_DRAIN = false;
    const float* basef; const bf16_t* baseb; bf16_t* outb; float* ssq;
    __device__ __forceinline__ void operator()(const f32x4 (&acc)[2][2][4][2], const Unit& u, int wr, int wc, int fr, int fq) const {
        const int row0 = u.pm * BM + wr * 64 + fr;
#pragma unroll
        for (int ai = 0; ai < 2; ++ai)
#pragma unroll
            for (int m = 0; m < 4; ++m) { const int row = row0 + ai * HALF + m * 16; float s = 0.f;
#pragma unroll
                for (int bj = 0; bj < 2; ++bj) { const size_t c = (size_t)row * 2048 + u.pn * BM + bj * HALF + wc * 32 + 8 * fq;
                    f32x4 v0 = acc[ai][bj][m][0], v1 = acc[ai][bj][m][1];
                    if (basef) { v0 += *(const f32x4*)(basef + c); v1 += *(const f32x4*)(basef + c + 4); }
                    else { const u32x4 b = *(const u32x4*)(baseb + c);
                        v0[0] += bflo(b.x); v0[1] += bfhi(b.x); v0[2] += bflo(b.y); v0[3] += bfhi(b.y); v1[0] += bflo(b.z); v1[1] += bfhi(b.z); v1[2] += bflo(b.w); v1[3] += bfhi(b.w); }
                    s += ((v0[0] * v0[0] + v0[1] * v0[1]) + (v0[2] * v0[2] + v0[3] * v0[3])) + ((v1[0] * v1[0] + v1[1] * v1[1]) + (v1[2] * v1[2] + v1[3] * v1[3]));
                    u32x4 w; w.x = pkbf(v0[0], v0[1]); w.y = pkbf(v0[2], v0[3]); w.z = pkbf(v1[0], v1[1]); w.w = pkbf(v1[2], v1[3]);
                    *(u32x4*)(outb + c) = w; }
                s += __shfl_xor(s, 16); s += __shfl_xor(s, 32);
                if (fq == 0) atomicAdd(ssq + row, s);
                asm volatile("" ::: "memory"); }
    }
};
struct EpiPle3 {
    static constexpr bool PERM = true, AFTER_DRAIN = false;
    bf16_t* xb; const bf16_t* g; float* ssq_out;
    __device__ __forceinline__ void operator()(const f32x4 (&acc)[2][2][4][2], const Unit& u, int wr, int wc, int fr, int fq) const {
        const int row0 = u.pm * BM + wr * 64 + fr;
#pragma unroll
        for (int ai = 0; ai < 2; ++ai)
#pragma unroll
            for (int m = 0; m < 4; ++m) { const int row = row0 + ai * HALF + m * 16; float s = 0.f;
#pragma unroll
                for (int bj = 0; bj < 2; ++bj) { const size_t c = (size_t)row * 2048 + u.pn * BM + bj * HALF + wc * 32 + 8 * fq;
                    const f32x4 a0 = acc[ai][bj][m][0], a1 = acc[ai][bj][m][1]; const u32x4 b = *(const u32x4*)(xb + c), gw = *(const u32x4*)(g + c);
                    f32x4 v0, v1;
                    v0[0] = bflo(b.x) + bflo(gw.x) * a0[0]; v0[1] = bfhi(b.x) + bfhi(gw.x) * a0[1]; v0[2] = bflo(b.y) + bflo(gw.y) * a0[2]; v0[3] = bfhi(b.y) + bfhi(gw.y) * a0[3];
                    v1[0] = bflo(b.z) + bflo(gw.z) * a1[0]; v1[1] = bfhi(b.z) + bfhi(gw.z) * a1[1]; v1[2] = bflo(b.w) + bflo(gw.w) * a1[2]; v1[3] = bfhi(b.w) + bfhi(gw.w) * a1[3];
                    s += ((v0[0] * v0[0] + v0[1] * v0[1]) + (v0[2] * v0[2] + v0[3] * v0[3])) + ((v1[0] * v1[0] + v1[1] * v1[1]) + (v1[2] * v1[2] + v1[3] * v1[3]));
                    u32x4 w; w.x = pkbf(v0[0], v0[1]); w.y = pkbf(v0[2], v0[3]); w.z = pkbf(v1[0], v1[1]); w.w = pkbf(v1[2], v1[3]);
                    *(u32x4*)(xb + c) = w; }
                s += __shfl_xor(s, 16); s += __shfl_xor(s, 32);
                if (fq == 0) atomicAdd(ssq_out + row, s);
                asm volatile("" ::: "memory"); }
    }
};


template <class Epi, class Sched, bool ALIGN_EPI = false, bool SP2 = false>
__device__ __forceinline__ void gemm_phase(PG8_LAS unsigned char* lds, const Gemm g, const Sched& S, const Epi& E) {
    const int tid = threadIdx.x, wid = __builtin_amdgcn_readfirstlane(tid >> 6), lane = tid & 63, wr = wid >> 2, wc = wid & 3, fr = lane & 15, fq = lane >> 4;
    const int K = g.K, nt = K / BK;
    unsigned voffA[2], voffB[2];
#pragma unroll
    for (int i = 0; i < 2; ++i) { int R, C; stage_rc(tid * 16 + i * 8192, R, C); const int Rb = Epi::PERM ? ((R & ~31) + perm32(R & 31)) : R;
        voffA[i] = (unsigned)(R * K + C) * 2u; voffB[i] = (unsigned)(Rb * K + C) * 2u; }
    const size_t kstep = (size_t)(BK * 2);
    const size_t hstep = (size_t)HALF * K * 2;
    const size_t tstep = 2 * hstep;
    const unsigned ldsw = (unsigned)wid * 1024u;
    const int aoff = lds_byte(wr * 64 + fr, fq * 8), boff = lds_byte(wc * 32 + fr, fq * 8);
#define PG8_SA(b, h) (((b) * 2 + (h)) * HTB)
#define PG8_SB(b, h) ((4 + (b) * 2 + (h)) * HTB)
#define PG8_STAGE(bufoff, gbase, voff) do { _Pragma("unroll") for (int _i = 0; _i < 2; ++_i) \
        __builtin_amdgcn_global_load_lds((const unsigned*)((const char*)(gbase) + (voff)[_i]), (PG8_LAS unsigned*)(lds + (bufoff) + ldsw + _i * 8192), 16, 0, 0); } while (0)
#define PG8_LDA(dst, b, h) do { _Pragma("unroll") for (int m = 0; m < 4; ++m) _Pragma("unroll") for (int k = 0; k < 2; ++k) dst[m][k] = *(const PG8_LAS bf16x8*)(lds + PG8_SA(b, h) + aoff + m * 2048 + k * 1024); } while (0)
#define PG8_LDB(dst, b, h) do { _Pragma("unroll") for (int n = 0; n < 2; ++n) _Pragma("unroll") for (int k = 0; k < 2; ++k) dst[n][k] = *(const PG8_LAS bf16x8*)(lds + PG8_SB(b, h) + boff + n * 2048 + k * 1024); } while (0)
#define PG8_MMA(ai, bj, At, Bt) do { __builtin_amdgcn_s_setprio(1); _Pragma("unroll") for (int m = 0; m < 4; ++m) _Pragma("unroll") for (int n = 0; n < 2; ++n) _Pragma("unroll") for (int k = 0; k < 2; ++k) \
        acc[ai][bj][m][n] = __builtin_amdgcn_mfma_f32_16x16x32_bf16(Bt[n][k], At[m][k], acc[ai][bj][m][n], 0, 0, 0); __builtin_amdgcn_s_setprio(0); } while (0)
#define PG8_WAIT_V(n) asm volatile("s_waitcnt vmcnt(" #n ")" ::: "memory")
#define PG8_WAIT_L(n) asm volatile("s_waitcnt lgkmcnt(" #n ")" ::: "memory")
#define PG8_BAR __builtin_amdgcn_s_barrier()
#define PG8_SCHED __builtin_amdgcn_sched_barrier(0)
    Unit cur, nxt; int ui = 0;
    if (!S.next(0, cur)) return;
    f32x4 acc[2][2][4][2];
#pragma unroll
    for (int a = 0; a < 2; ++a)
#pragma unroll
        for (int b = 0; b < 2; ++b)
#pragma unroll
            for (int m = 0; m < 4; ++m)
#pragma unroll
                for (int n = 0; n < 2; ++n) acc[a][b][m][n] = (f32x4){0.f, 0.f, 0.f, 0.f};
    bf16x8 At[4][2], B0[2][2], B1[2][2];
    const char* cA = (const char*)g.A + (size_t)cur.pm * tstep; const char* cB = (const char*)g.Bt + (size_t)cur.pn * tstep;
    S.a_ready(cur);
    if constexpr (SP2) {
        PG8_STAGE(PG8_SB(0, 0), cB, voffB); PG8_STAGE(PG8_SB(0, 1), cB + hstep, voffB); PG8_STAGE(PG8_SA(0, 0), cA, voffA); PG8_STAGE(PG8_SA(0, 1), cA + hstep, voffA);
        if (wr == 1) PG8_BAR;
        PG8_WAIT_V(2); PG8_BAR;
        PG8_STAGE(PG8_SB(1, 0), cB + kstep, voffB); PG8_STAGE(PG8_SA(1, 0), cA + kstep, voffA); PG8_STAGE(PG8_SB(1, 1), cB + hstep + kstep, voffB);
        PG8_WAIT_V(6); PG8_BAR;
    } else {
        PG8_STAGE(PG8_SB(0, 0), cB, voffB); PG8_STAGE(PG8_SA(0, 0), cA, voffA); PG8_STAGE(PG8_SB(0, 1), cB + hstep, voffB); PG8_STAGE(PG8_SA(0, 1), cA + hstep, voffA);
        if (wr == 1) PG8_BAR;
        PG8_WAIT_V(4); PG8_BAR;
        PG8_STAGE(PG8_SB(1, 0), cB + kstep, voffB); PG8_STAGE(PG8_SA(1, 0), cA + kstep, voffA); PG8_STAGE(PG8_SB(1, 1), cB + hstep + kstep, voffB);
        PG8_WAIT_V(6); PG8_BAR;
    }
    for (;;) {
        const bool has_next = S.next(ui + 1, nxt);
        const char* nA = has_next ? (const char*)g.A + (size_t)nxt.pm * tstep : cA; const char* nB = has_next ? (const char*)g.Bt + (size_t)nxt.pn * tstep : cB;
        for (int t = 0; t < nt; t += 2) {
            const bool last = (t == nt - 2);
            const char* a1 = cA + (size_t)(t + 1) * kstep;
            const char* a2 = last ? nA : cA + (size_t)(t + 2) * kstep; const char* b2 = last ? nB : cB + (size_t)(t + 2) * kstep;
            const char* a3 = a2 + kstep; const char* b3 = b2 + kstep;
            if (last && has_next) S.a_ready(nxt);
            if constexpr (SP2) {
            PG8_LDB(B0, 0, 0); PG8_LDB(B1, 0, 1); PG8_SCHED; PG8_LDA(At, 0, 0); PG8_STAGE(PG8_SA(1, 1), a1 + hstep, voffA);
            PG8_WAIT_V(8); PG8_WAIT_L(0); PG8_BAR; PG8_MMA(0, 0, At, B0); PG8_MMA(0, 1, At, B1); PG8_BAR; PG8_SCHED;
            PG8_LDA(At, 0, 1); PG8_STAGE(PG8_SB(0, 0), b2, voffB); PG8_STAGE(PG8_SB(0, 1), b2 + hstep, voffB); PG8_STAGE(PG8_SA(0, 0), a2, voffA);
            PG8_WAIT_V(8); PG8_WAIT_L(0); PG8_BAR; PG8_MMA(1, 0, At, B0); PG8_MMA(1, 1, At, B1); PG8_BAR; PG8_SCHED;
            PG8_LDB(B0, 1, 0); PG8_LDB(B1, 1, 1); PG8_SCHED; PG8_LDA(At, 1, 0); PG8_STAGE(PG8_SA(0, 1), a2 + hstep, voffA);
            PG8_WAIT_V(8); PG8_WAIT_L(0); PG8_BAR; PG8_MMA(0, 0, At, B0); PG8_MMA(0, 1, At, B1); PG8_BAR; PG8_SCHED;
            PG8_LDA(At, 1, 1); PG8_STAGE(PG8_SB(1, 0), b3, voffB); PG8_STAGE(PG8_SB(1, 1), b3 + hstep, voffB); PG8_STAGE(PG8_SA(1, 0), a3, voffA);
            PG8_WAIT_V(8); PG8_WAIT_L(0); PG8_BAR; PG8_MMA(1, 0, At, B0); PG8_MMA(1, 1, At, B1); PG8_BAR; PG8_SCHED;
            } else {
            PG8_LDB(B0, 0, 0); PG8_SCHED; PG8_LDA(At, 0, 0); PG8_STAGE(PG8_SA(1, 1), a1 + hstep, voffA);
            PG8_WAIT_L(8); PG8_BAR; PG8_WAIT_L(0); PG8_MMA(0, 0, At, B0); PG8_BAR; PG8_SCHED;
            PG8_LDB(B1, 0, 1); PG8_STAGE(PG8_SB(0, 0), b2, voffB);
            PG8_BAR; PG8_WAIT_L(0); PG8_MMA(0, 1, At, B1); PG8_BAR;
            PG8_LDA(At, 0, 1); PG8_STAGE(PG8_SA(0, 0), a2, voffA);
            PG8_BAR; PG8_WAIT_L(0); PG8_MMA(1, 0, At, B0); PG8_BAR; PG8_SCHED;
            PG8_STAGE(PG8_SB(0, 1), b2 + hstep, voffB);
            PG8_WAIT_V(6); PG8_BAR; PG8_MMA(1, 1, At, B1); PG8_BAR;
            PG8_LDB(B0, 1, 0); PG8_SCHED; PG8_LDA(At, 1, 0); PG8_STAGE(PG8_SA(0, 1), a2 + hstep, voffA);
            PG8_WAIT_L(8); PG8_BAR; PG8_WAIT_L(0); PG8_MMA(0, 0, At, B0); PG8_BAR; PG8_SCHED;
            PG8_LDB(B1, 1, 1); PG8_STAGE(PG8_SB(1, 0), b3, voffB);
            PG8_BAR; PG8_WAIT_L(0); PG8_MMA(0, 1, At, B1); PG8_BAR;
            PG8_LDA(At, 1, 1); PG8_STAGE(PG8_SA(1, 0), a3, voffA);
            PG8_BAR; PG8_WAIT_L(0); PG8_MMA(1, 0, At, B0); PG8_BAR; PG8_SCHED;
            PG8_STAGE(PG8_SB(1, 1), b3 + hstep, voffB);
            PG8_WAIT_V(6); PG8_BAR; PG8_MMA(1, 1, At, B1); PG8_BAR;
            }
        }
        if constexpr (ALIGN_EPI) { if (wr == 0) PG8_BAR; }
        if constexpr (!Epi::AFTER_DRAIN) { E(acc, cur, wr, wc, fr, fq); S.done(cur); }
        if (!has_next) break;
#pragma unroll
        for (int a = 0; a < 2; ++a)
#pragma unroll
            for (int b = 0; b < 2; ++b)
#pragma unroll
                for (int m = 0; m < 4; ++m)
#pragma unroll
                    for (int n = 0; n < 2; ++n) acc[a][b][m][n] = (f32x4){0.f, 0.f, 0.f, 0.f};
        cur = nxt; cA = nA; cB = nB; ++ui;
        if constexpr (ALIGN_EPI) { if (wr == 1) PG8_BAR; }
    }
    PG8_WAIT_V(0);
    if constexpr (!ALIGN_EPI) { if (wr == 0) PG8_BAR; }
    PG8_BAR;
    if constexpr (Epi::AFTER_DRAIN) { E.fused(acc, cur, wr, wc, fr, fq, lds, wid, lane); S.done(cur); }
#undef PG8_SA
#undef PG8_SB
#undef PG8_STAGE
#undef PG8_LDA
#undef PG8_LDB
#undef PG8_MMA
#undef PG8_WAIT_V
#undef PG8_WAIT_L
#undef PG8_BAR
#undef PG8_SCHED
}
}

#ifndef PG8_SP2
#define PG8_SP2 true
#endif
#ifndef PG8_ALIGN
#define PG8_ALIGN true
#endif
#ifndef REPEAT_PHASE
#define REPEAT_PHASE -1
#endif
#define NREP(k) ((k) == REPEAT_PHASE ? 2 : 1)
#ifndef EXTRA_PHASE
#define EXTRA_PHASE -1
#endif
#ifndef PG8_ALIGN_HEAVY
#define PG8_ALIGN_HEAVY true
#endif
#ifndef MK_N_LAUNCHES
#define MK_N_LAUNCHES 1
#endif
#define LAS __attribute__((address_space(3)))
using pg8::bf16_t; using pg8::bf16x8; using pg8::f32x4; using pg8::u32x4; using pg8::u32x2; using pg8::pkbf; using pg8::bflo; using pg8::bfhi; using pg8::sigm; using pg8::RMS_EPS;
typedef float f32x16 __attribute__((ext_vector_type(16)));
#define MFMA32(a, b, c) __builtin_amdgcn_mfma_f32_32x32x16_bf16((a), (b), (c), 0, 0, 0)
#define MFMA16(a, b, c) __builtin_amdgcn_mfma_f32_16x16x32_bf16((a), (b), (c), 0, 0, 0)

constexpr int T = 16384, DM = 2048, DFF = 8192, INC = 11272, NPH = 11;
constexpr size_t MiB = (size_t)1 << 20;
constexpr size_t WS_MISC = 0, WS_QF = 224 * MiB, WS_KF = 256 * MiB, WS_VTF = 288 * MiB, WS_MVT = 320 * MiB, WS_MERGED = 352 * MiB;
constexpr size_t WS_WIN = 416 * MiB, WS_WVT = 452 * MiB, WS_WPA = 460 * MiB, WS_WPB = 464 * MiB, WS_WO = 468 * MiB, WS_WPG = 476 * MiB, WS_WPP = 484 * MiB, WS_PB = 485 * MiB;
constexpr size_t WS_GATES = 493 * MiB, WS_SS = 494 * MiB, WS_CTL = 496 * MiB, CTL_BYTES = 16384, WS_END = 497 * MiB;
constexpr int LDS_XB = 147392;
constexpr size_t WS_ACT = 0, WS_PP = 0, WS_XB = 256 * MiB, WS_WUP = 320 * MiB, WS_WDOWN = 416 * MiB;
constexpr size_t DO_H = 0, DO_YA = 0, DO_YB = 32 * MiB, DO_HRAW = 64 * MiB, DO_KCT = 96 * MiB;
constexpr size_t WS_QC = 352 * MiB, WS_KC = 384 * MiB;
constexpr int LDS_BYTES = 147456;

__device__ __forceinline__ float wave_sum(float v) {
#pragma unroll
    for (int o = 1; o < 64; o <<= 1) v += __shfl_xor(v, o);
    return v;
}
#define LDS_WAIT() asm volatile("s_waitcnt lgkmcnt(0)" ::: "memory")

__device__ __forceinline__ void transpose_item(const float* W, int ldw, int K, int srccol, const float* gain, bf16_t* WT, int n0, int k0, LAS float* scr, int lane) {
#pragma unroll 8
    for (int i = 0; i < 32; ++i) { const int kk = 2 * i + (lane >> 5); float v = W[(size_t)(k0 + kk) * ldw + srccol + (lane & 31)]; if (gain) v *= gain[k0 + kk]; scr[kk * 33 + (lane & 31)] = v; }
    LDS_WAIT();
    const int c = lane & 7;
#pragma unroll
    for (int j = 0; j < 4; ++j) { const int n = (lane >> 3) + 8 * j; const LAS float* s = scr + (8 * c) * 33 + n;
        u32x4 o; o.x = pkbf(s[0 * 33], s[1 * 33]); o.y = pkbf(s[2 * 33], s[3 * 33]); o.z = pkbf(s[4 * 33], s[5 * 33]); o.w = pkbf(s[6 * 33], s[7 * 33]);
        *(u32x4*)(WT + (size_t)(n0 + n) * K + k0 + 8 * c) = o; }
    LDS_WAIT();
}
__device__ __forceinline__ void transpose_job(const float* W, int ldw, int K, int N, const float* gain, bf16_t* WT, int mode, LAS float* scr, int gw, int NGW, int lane) {
    const int nblk = N / 32, items = (K / 64) * nblk;
    for (int it = gw; it < items; it += NGW) {
        const int kb = it / nblk, nb = it % nblk, n0 = 32 * nb;
        int src = n0;
        if (mode == 1) src = n0 < 2048 ? n0 : (n0 < 4096 ? n0 + 1024 : (n0 < 5120 ? n0 + 2048 : n0 + 2056));
        if (mode == 2) src = n0 < 1024 ? n0 + 2048 : n0 + 4096;
        transpose_item(W, ldw, K, src, gain, WT, n0, 64 * kb, scr, lane);
    }
}

__device__ __forceinline__ void attn_block_unit2(LAS unsigned char* lds, const bf16_t* __restrict__ Qf, const bf16_t* __restrict__ Kf, const bf16_t* __restrict__ VtF, bf16_t* __restrict__ ya, const float* __restrict__ subg, float lam,
                                                 int bh, int j, int tid, int wid, int lane) {
    const int r32 = lane & 31, hi = lane >> 5, qg = 8 * j + wid, nst = 4 * j + 4, myst = 4 * j + (wid >> 1) + 1;
    const int foff = hi * 512 + r32 * 16;
    LAS unsigned* park = (LAS unsigned*)(lds + 49152 + wid * 8192) + lane;
    const bf16_t* gv = VtF + (size_t)(bh * 64) * 4096 + tid * 8;
    f32x16 o[4];
#pragma unroll 1
    for (int mp = 0; mp < 2; ++mp) {
        bf16x8 q[4];
#pragma unroll
        for (int d0 = 0; d0 < 4; ++d0) q[d0] = *(const bf16x8*)(Qf + ((size_t)(((((bh * 2 + mp) * 64 + qg) * 4 + d0) * 2 + hi)) * 32 + r32) * 8);
        const bf16_t* gk = Kf + (size_t)((bh * 2 + mp) * 64) * 2048 + tid * 8;
        o[0] = f32x16{}; o[1] = f32x16{}; o[2] = f32x16{}; o[3] = f32x16{};
        float mrun = 0.f; bool first = true;
        f32x16 negm = {}, ol = {};
        const unsigned omsk = (r32 == 0) ? 0x3F803F80u : 0u; u32x4 ow4; ow4.x = omsk; ow4.y = omsk; ow4.z = omsk; ow4.w = omsk; const bf16x8 onesf = __builtin_bit_cast(bf16x8, ow4);
        u32x4 pk = *(const u32x4*)gk, pv0 = *(const u32x4*)gv, pv1 = *(const u32x4*)(gv + 4096);
        *(LAS u32x4*)(lds + tid * 16) = pk; *(LAS u32x4*)(lds + 8192 + tid * 16) = pv0; *(LAS u32x4*)(lds + 16384 + tid * 16) = pv1;
        __syncthreads();
        for (int st = 0; st < nst; ++st) {
            LAS unsigned char* buf = lds + (st & 1) * 24576; LAS unsigned char* nbuf = lds + ((st + 1) & 1) * 24576;
            if (st + 1 < nst) { pk = *(const u32x4*)(gk + (size_t)(st + 1) * 4096); pv0 = *(const u32x4*)(gv + (size_t)(st + 1) * 8192); pv1 = *(const u32x4*)(gv + (size_t)(st + 1) * 8192 + 4096); }
            if (st < myst) {
#pragma unroll
                for (int u = 0; u < 2; ++u) {
                    f32x16 sc = negm;
#pragma unroll
                    for (int d0 = 0; d0 < 4; ++d0) { const bf16x8 kf = *(const LAS bf16x8*)(buf + u * 4096 + d0 * 1024 + foff); sc = MFMA32(kf, q[d0], sc); }
                    float t = sc[0];
#pragma unroll
                    for (int r = 1; r < 16; ++r) t = fmaxf(t, sc[r]);
                    t = fmaxf(t, __shfl_xor(t, 32));
                    if (first || __any(t > 0.f)) {
                        const float n = first ? t : fmaxf(t, 0.f), al = first ? 0.f : __builtin_amdgcn_exp2f(-n);
                        ol[0] *= al;
#pragma unroll
                        for (int eb = 0; eb < 4; ++eb)
#pragma unroll
                            for (int r = 0; r < 16; ++r) o[eb][r] *= al;
                        mrun += n;
#pragma unroll
                        for (int r = 0; r < 16; ++r) { negm[r] = -mrun; sc[r] -= n; }
                        first = false;
                    }
                    float p[16];
#pragma unroll
                    for (int r = 0; r < 16; ++r) p[r] = __builtin_amdgcn_exp2f(sc[r]);
                    u32x4 w0, w1; w0.x = pkbf(p[0], p[1]); w0.y = pkbf(p[2], p[3]); w0.z = pkbf(p[4], p[5]); w0.w = pkbf(p[6], p[7]);
                    w1.x = pkbf(p[8], p[9]); w1.y = pkbf(p[10], p[11]); w1.z = pkbf(p[12], p[13]); w1.w = pkbf(p[14], p[15]);
                    const bf16x8 pf0 = __builtin_bit_cast(bf16x8, w0), pf1 = __builtin_bit_cast(bf16x8, w1);
                    ol = MFMA32(onesf, pf0, ol); ol = MFMA32(onesf, pf1, ol);
#pragma unroll
                    for (int eb = 0; eb < 4; ++eb) { const bf16x8 v0 = *(const LAS bf16x8*)(buf + 8192 + u * 8192 + (eb * 2 + 0) * 1024 + foff), v1 = *(const LAS bf16x8*)(buf + 8192 + u * 8192 + (eb * 2 + 1) * 1024 + foff);
                        o[eb] = MFMA32(v0, pf0, o[eb]); o[eb] = MFMA32(v1, pf1, o[eb]); }
                }
            }
            if (st + 1 < nst) { *(LAS u32x4*)(nbuf + tid * 16) = pk; *(LAS u32x4*)(nbuf + 8192 + tid * 16) = pv0; *(LAS u32x4*)(nbuf + 16384 + tid * 16) = pv1; }
            __syncthreads();
        }
        const float lrun = __shfl(ol[0], r32);
        if (mp == 0) { const float il = 1.f / lrun;
#pragma unroll
            for (int eb = 0; eb < 4; ++eb)
#pragma unroll
                for (int r = 0; r < 16; r += 2) park[(eb * 8 + (r >> 1)) * 64] = pkbf(o[eb][r] * il, o[eb][r + 1] * il);
        } else { const float c2 = -lam / lrun;
#pragma unroll
            for (int eb = 0; eb < 4; ++eb)
#pragma unroll
                for (int r = 0; r < 16; r += 2) { const unsigned w = park[(eb * 8 + (r >> 1)) * 64]; o[eb][r] = bflo(w) + c2 * o[eb][r]; o[eb][r + 1] = bfhi(w) + c2 * o[eb][r + 1]; }
        }
    }
    float ss = 0.f;
#pragma unroll
    for (int eb = 0; eb < 4; ++eb)
#pragma unroll
        for (int r = 0; r < 16; ++r) ss += o[eb][r] * o[eb][r];
    ss += __shfl_xor(ss, 32);
    const float rn = __builtin_amdgcn_rsqf(ss * (1.f / 128.f) + RMS_EPS) * 0.8f;
    const int b = bh >> 3, h = bh & 7;
    bf16_t* dst = ya + (size_t)(b * 2048 + qg * 32 + r32) * 1024 + h * 128;
#pragma unroll
    for (int eb = 0; eb < 4; ++eb)
#pragma unroll
        for (int g = 0; g < 4; ++g) { const int e0 = 32 * eb + 8 * g + 4 * hi; const f32x4 gg = *(const f32x4*)(subg + e0);
            u32x2 w; w.x = pkbf(o[eb][4 * g] * rn * gg[0], o[eb][4 * g + 1] * rn * gg[1]); w.y = pkbf(o[eb][4 * g + 2] * rn * gg[2], o[eb][4 * g + 3] * rn * gg[3]);
            *(u32x2*)(dst + e0) = w; }
}

__device__ __forceinline__ void conv_prepass2(LAS unsigned char* lds, const bf16_t* __restrict__ MISC_, const float* __restrict__ conv_w, const float* __restrict__ conv_b, bf16_t* __restrict__ QC_, bf16_t* __restrict__ KC_, bf16_t* __restrict__ KCT_,
                                              int blk, int nblk, int tid) {
    constexpr int TPK = 72;
    LAS bf16_t* tile = (LAS bf16_t*)lds;
    const int cpl = tid & 255, th = tid >> 8;
    for (int it = blk; it < 1024; it += nblk) {
        const int cg_ = it & 3, tb = it >> 2, ch = cg_ * 512 + 2 * cpl, trow0 = tb * 64 + th * 32; const bool isk = cg_ >= 2, seqstart = (trow0 & 2047) == 0;
        const bf16_t* src = MISC_ + (size_t)trow0 * 7168 + ch;
        float cw0[4], cw1[4];
#pragma unroll
        for (int j = 0; j < 4; ++j) { cw0[j] = conv_w[j * 2048 + ch]; cw1[j] = conv_w[j * 2048 + ch + 1]; }
        const float cb0 = conv_b[ch], cb1 = conv_b[ch + 1], osc = isk ? 1.f : 0.0625f;
        bf16_t* dst = (isk ? KC_ : QC_) + (size_t)trow0 * 1024 + (ch & 1023);
        float xa[3], xb[3];
#pragma unroll
        for (int j = 0; j < 3; ++j) { unsigned w = 0u; if (!seqstart) w = *(const unsigned*)(src - (size_t)(3 - j) * 7168); xa[j] = bflo(w); xb[j] = bfhi(w); }
#pragma unroll
        for (int g = 0; g < 4; ++g) {
            float ya_[8], yb_[8];
#pragma unroll
            for (int i = 0; i < 8; ++i) { const int tt = g * 8 + i;
                const unsigned w = *(const unsigned*)(src + (size_t)tt * 7168); const float x0 = bflo(w), x1 = bfhi(w);
                float y0 = cb0 + cw0[0] * xa[0] + cw0[1] * xa[1] + cw0[2] * xa[2] + cw0[3] * x0;
                float y1 = cb1 + cw1[0] * xb[0] + cw1[1] * xb[1] + cw1[2] * xb[2] + cw1[3] * x1;
                xa[0] = xa[1]; xa[1] = xa[2]; xa[2] = x0; xb[0] = xb[1]; xb[1] = xb[2]; xb[2] = x1;
                y0 = y0 * sigm(y0) * osc; y1 = y1 * sigm(y1) * osc; ya_[i] = y0; yb_[i] = y1;
                *(unsigned*)(dst + (size_t)tt * 1024) = pkbf(y0, y1); }
            if (isk) {
                u32x4 wa, wb; wa.x = pkbf(ya_[0], ya_[1]); wa.y = pkbf(ya_[2], ya_[3]); wa.z = pkbf(ya_[4], ya_[5]); wa.w = pkbf(ya_[6], ya_[7]);
                wb.x = pkbf(yb_[0], yb_[1]); wb.y = pkbf(yb_[2], yb_[3]); wb.z = pkbf(yb_[4], yb_[5]); wb.w = pkbf(yb_[6], yb_[7]);
                *(LAS u32x4*)(tile + (2 * cpl) * TPK + th * 32 + g * 8) = wa; *(LAS u32x4*)(tile + (2 * cpl + 1) * TPK + th * 32 + g * 8) = wb; }
        }
        if (isk) {
            __syncthreads();
#pragma unroll
            for (int i = 0; i < 8; ++i) { const int idx = tid + 512 * i, row = idx >> 3, seg = idx & 7;
                *(u32x4*)(KCT_ + (size_t)((cg_ - 2) * 512 + row) * 16384 + tb * 64 + 8 * seg) = *(const LAS u32x4*)(tile + row * TPK + 8 * seg); }
            __syncthreads();
        }
    }
}

__device__ __forceinline__ void mlstm_unit(LAS unsigned char* lds, const bf16_t* __restrict__ QC, const bf16_t* __restrict__ KC, const bf16_t* __restrict__ KCT, const bf16_t* __restrict__ MvT, const float* __restrict__ gates,
                                           bf16_t* __restrict__ hraw, int b, int hh, int es, int tid, int wid, int lane) {
    constexpr int QP = 264, TP = 72;
    LAS bf16_t* qs = (LAS bf16_t*)(lds);
    LAS bf16_t* ks = (LAS bf16_t*)(lds + 33792);
    LAS bf16_t* kT = (LAS bf16_t*)(lds + 67584);
    LAS bf16_t* Cb = (LAS bf16_t*)(lds + 104448);
    LAS bf16_t* Sb = (LAS bf16_t*)(lds + 121344);
    LAS float* nvec = (LAS float*)(lds + 130560);
    LAS float* aS = (LAS float*)(lds + 132608);
    LAS float* ML = aS + 64; LAS float* IW = aS + 128; LAS float* EM = aS + 192; LAS float* WS = aS + 256;
    LAS bf16_t* Vs = (LAS bf16_t*)(lds + 134144);
    LAS bf16_t* Vw = (LAS bf16_t*)(lds + 138752);
    LAS bf16_t* nb16 = (LAS bf16_t*)(lds + 143360);
    const int r32 = lane & 31, hi = lane >> 5, r16 = lane & 15, kq = lane >> 4, lt = wid >> 1, et = wid & 1;
    f32x16 C = {};
    if (tid < 256) { nvec[tid] = 0.f; nb16[tid] = 0; }
    float m_prev = 0.f;
    const bf16_t* qsrc = QC + (size_t)(b * 2048) * 1024 + hh * 256;
    const bf16_t* ksrc = KC + (size_t)(b * 2048) * 1024 + hh * 256;
    const bf16_t* ktsrc = KCT + (size_t)(hh * 256) * 16384 + b * 2048;
    const float* gsrc = gates + (size_t)(b * 2048 + lane) * 8 + hh;
    const bf16_t* vsrc = MvT + (size_t)(hh * 256 + es * 32 + (tid >> 4)) * 16384 + b * 2048 + 4 * (tid & 15);
    u32x4 pq[4], pk[4], pt[4]; float pli, plf; u32x2 pv;
#define ML_PREFETCH(cc) do { \
        _Pragma("unroll") for (int i = 0; i < 4; ++i) { const int idx = tid + 512 * i; \
            pq[i] = *(const u32x4*)(qsrc + (size_t)((cc) * 64 + (idx >> 5)) * 1024 + 8 * (idx & 31)); pk[i] = *(const u32x4*)(ksrc + (size_t)((cc) * 64 + (idx >> 5)) * 1024 + 8 * (idx & 31)); \
            } \
        pli = gsrc[(size_t)(cc) * 512]; plf = gsrc[(size_t)(cc) * 512 + 4]; } while (0)
#define ML_PREFETCH2(cc) do { \
        _Pragma("unroll") for (int i = 0; i < 4; ++i) { const int idx = tid + 512 * i; pt[i] = *(const u32x4*)(ktsrc + (size_t)(idx >> 3) * 16384 + (cc) * 64 + 8 * (idx & 7)); } \
        pv = *(const u32x2*)(vsrc + (cc) * 64); } while (0)
    ML_PREFETCH(0); ML_PREFETCH2(0);
    for (int c = 0; c < 32; ++c) {
        const int t0 = b * 2048 + c * 64;
        LAS float* nv_cur = nvec + (c & 1) * 256; LAS float* nv_nxt = nvec + ((c + 1) & 1) * 256;
        LAS bf16_t* nb_cur = nb16 + (c & 1) * 256; LAS bf16_t* nb_nxt = nb16 + ((c + 1) & 1) * 256;
        const float li = pli, lf = plf;
        float bc = lf;
#pragma unroll
        for (int o = 1; o < 64; o <<= 1) { const float v = __shfl_up(bc, o); if (lane >= o) bc += v; }
        const float a = li - bc; float A = a;
#pragma unroll
        for (int o = 1; o < 64; o <<= 1) { const float v = __shfl_up(A, o); if (lane >= o) A = fmaxf(A, v); }
        const float Mx = fmaxf(m_prev, A), iw = __expf(m_prev - Mx), em = __expf(-(bc + Mx));
        const float M63 = fmaxf(m_prev, __shfl(A, 63)), wsv = __expf(a - M63), decay = __expf(m_prev - M63), m_new = __shfl(bc, 63) + M63;
        if (wid == 0) { aS[lane] = a; ML[lane] = Mx; IW[lane] = iw; EM[lane] = em; WS[lane] = wsv; }
#pragma unroll
        for (int i = 0; i < 4; ++i) { const int idx = tid + 512 * i;
            *(LAS u32x4*)(qs + (idx >> 5) * QP + 8 * (idx & 31)) = pq[i]; *(LAS u32x4*)(ks + (idx >> 5) * QP + 8 * (idx & 31)) = pk[i]; *(LAS u32x4*)(kT + (idx >> 3) * TP + 8 * (idx & 7)) = pt[i]; }
        { const int sb = 4 * (tid & 15);
            *(LAS u32x2*)(Vs + (tid >> 4) * TP + sb) = pv;
            u32x2 sv; sv.x = pkbf(bflo(pv.x) * __shfl(wsv, sb), bfhi(pv.x) * __shfl(wsv, sb + 1)); sv.y = pkbf(bflo(pv.y) * __shfl(wsv, sb + 2), bfhi(pv.y) * __shfl(wsv, sb + 3));
            *(LAS u32x2*)(Vw + (tid >> 4) * TP + sb) = sv; }
        if (c + 1 < 32) ML_PREFETCH(c + 1);
        __syncthreads();
#pragma unroll
        for (int sti = 0; sti < 2; ++sti) { const int st = 2 * (wid & 1) + sti; f32x4 g4 = {0.f, 0.f, 0.f, 0.f};
            if (st <= lt) {
#pragma unroll
                for (int kb = 0; kb < 8; ++kb) { const bf16x8 af = *(const LAS bf16x8*)(qs + (16 * lt + r16) * QP + 32 * kb + 8 * kq), bf = *(const LAS bf16x8*)(ks + (16 * st + r16) * QP + 32 * kb + 8 * kq);
                    g4 = MFMA16(af, bf, g4); if (kb & 1) __builtin_amdgcn_sched_barrier(0); } }
            __builtin_amdgcn_sched_barrier(0);
            const int s = 16 * st + r16; const float as = aS[s];
#pragma unroll
            for (int r = 0; r < 4; ++r) { const int l = 16 * lt + 4 * kq + r; const float v = (s <= l) ? g4[r] * __expf(fminf(as - ML[l], 0.f)) : 0.f;
                Sb[l * TP + s] = (bf16_t)(pkbf(v, 0.f) & 0xffffu); } }
#pragma unroll
        for (int g = 0; g < 4; ++g) { u32x2 w; w.x = pkbf(C[4 * g], C[4 * g + 1]); w.y = pkbf(C[4 * g + 2], C[4 * g + 3]); *(LAS u32x2*)(Cb + r32 * QP + 32 * wid + 8 * g + 4 * hi) = w; }
        __syncthreads();
        f32x4 nm = {0.f, 0.f, 0.f, 0.f}, dn = {0.f, 0.f, 0.f, 0.f};
        const unsigned msk = (r16 == 0) ? 0xFFFFFFFFu : 0u;
#pragma unroll
        for (int kb = 0; kb < 8; ++kb) { const bf16x8 af = *(const LAS bf16x8*)(qs + (16 * lt + r16) * QP + 32 * kb + 8 * kq), bf = *(const LAS bf16x8*)(Cb + (16 * et + r16) * QP + 32 * kb + 8 * kq);
            u32x4 nw = *(const LAS u32x4*)(nb_cur + 32 * kb + 8 * kq); nw.x &= msk; nw.y &= msk; nw.z &= msk; nw.w &= msk; const bf16x8 nf = __builtin_bit_cast(bf16x8, nw);
            nm = MFMA16(af, bf, nm); dn = MFMA16(af, nf, dn); if (kb & 1) __builtin_amdgcn_sched_barrier(0); }
        __builtin_amdgcn_sched_barrier(0);
#pragma unroll
        for (int r = 0; r < 4; ++r) { const float w = IW[16 * lt + 4 * kq + r]; nm[r] *= w; dn[r] *= w; }
#pragma unroll
        for (int kb = 0; kb < 2; ++kb) { const bf16x8 af = *(const LAS bf16x8*)(Sb + (16 * lt + r16) * TP + 32 * kb + 8 * kq), bf = *(const LAS bf16x8*)(Vs + (16 * et + r16) * TP + 32 * kb + 8 * kq);
            u32x4 ow; ow.x = 0x3F803F80u & msk; ow.y = ow.x; ow.z = ow.x; ow.w = ow.x;
            nm = MFMA16(af, bf, nm); dn = MFMA16(af, __builtin_bit_cast(bf16x8, ow), dn); }
#pragma unroll
        for (int r = 0; r < 4; ++r) { const int l = 16 * lt + 4 * kq + r; const float dnv = fmaxf(fabsf(__shfl(dn[r], kq * 16)), EM[l]); const float hv = nm[r] / dnv;
            hraw[((size_t)((b * 4 + hh) * 8 + es) * 2048 + (c * 64 + l)) * 32 + 16 * et + r16] = (bf16_t)(pkbf(hv, 0.f) & 0xffffu); }
        if (c + 1 < 32) ML_PREFETCH2(c + 1);
#pragma unroll
        for (int i = 0; i < 16; ++i) C[i] *= decay;
#pragma unroll
        for (int kb = 0; kb < 4; ++kb) { const bf16x8 af = *(const LAS bf16x8*)(kT + (32 * wid + r32) * TP + 16 * kb + 8 * hi);
            const bf16x8 sv = *(const LAS bf16x8*)(Vw + r32 * TP + 16 * kb + 8 * hi);
            C = MFMA32(af, sv, C); __builtin_amdgcn_sched_barrier(0); }
        { const int d = tid >> 1, half = tid & 1; float sacc = 0.f;
#pragma unroll
            for (int i = 0; i < 4; ++i) { const u32x4 kw = *(const LAS u32x4*)(kT + d * TP + 32 * half + 8 * i); const f32x4 w0 = *(const LAS f32x4*)(WS + 32 * half + 8 * i), w1 = *(const LAS f32x4*)(WS + 32 * half + 8 * i + 4);
                sacc += bflo(kw.x) * w0[0] + bfhi(kw.x) * w0[1] + bflo(kw.y) * w0[2] + bfhi(kw.y) * w0[3] + bflo(kw.z) * w1[0] + bfhi(kw.z) * w1[1] + bflo(kw.w) * w1[2] + bfhi(kw.w) * w1[3];
                if (i & 1) __builtin_amdgcn_sched_barrier(0); }
            sacc += __shfl_xor(sacc, 1);
            if (half == 0) { const float nn = decay * nv_cur[d] + sacc; nv_nxt[d] = nn; nb_nxt[d] = (bf16_t)(pkbf(nn, 0.f) & 0xffffu); } }
        m_prev = m_new;
        __syncthreads();
    }
#undef ML_PREFETCH
#undef ML_PREFETCH2
}

#define XB_TMO      128
#define XB_XCNT(j)  (256  + 64 * (j))
#define XB_XSUB(j)  (1280 + 64 * (j))
#define XB_XGEN(j)  (2304 + 64 * (j))
#define XB_TOP      3328
#define XB_TOPGEN   3392
#define XCD_BAR_WORDS 3456
#define XB_SPIN_CAP (1u << 18)

__device__ __forceinline__ unsigned xb_ld(unsigned* p)              { return __hip_atomic_load(p, __ATOMIC_RELAXED, __HIP_MEMORY_SCOPE_AGENT); }
__device__ __forceinline__ unsigned xb_add(unsigned* p, unsigned v) { return __hip_atomic_fetch_add(p, v, __ATOMIC_RELAXED, __HIP_MEMORY_SCOPE_AGENT); }
__device__ __forceinline__ unsigned xb_xcc_id() { return (unsigned)__builtin_amdgcn_s_getreg((3 << 11) | 20) & 0xFu; }
#define XB_SPIN(cond, bar) do { unsigned _sp = 0; while (cond) { __builtin_amdgcn_s_sleep(1); \
    if ((++_sp & 255u) == 0u) { if (xb_ld(&(bar)[XB_TMO])) break; if (_sp > XB_SPIN_CAP) { atomicAdd(&(bar)[XB_TMO], 1u); break; } } } } while (0)

struct XcdBarrier {
    unsigned* bar; unsigned x;
    volatile LAS unsigned* st;
};

__device__ __forceinline__ XcdBarrier xcd_barrier_post(unsigned* bar, volatile LAS unsigned* st) {
    XcdBarrier b; b.bar = bar; b.x = xb_xcc_id(); b.st = st;
    if (threadIdx.x == 0) (void)xb_add(&bar[XB_XCNT(b.x)], 1u);
    return b;
}
__device__ __forceinline__ void xcd_barrier_complete(unsigned* bar, unsigned x, unsigned& nloc, unsigned& nx) {
    const unsigned G = gridDim.x * gridDim.y * gridDim.z;
    unsigned sum, cnt, mine, sp = 0u;
    for (;;) {
        sum = 0u; cnt = 0u; mine = 0u;
#pragma unroll
        for (unsigned j = 0; j < 16; ++j) { const unsigned c = xb_ld(&bar[XB_XCNT(j)]); sum += c; cnt += (c > 0u) ? 1u : 0u; mine = (j == x) ? c : mine; }
        if (sum == G) break;
        __builtin_amdgcn_s_sleep(1);
        if ((++sp & 255u) == 0u) { if (xb_ld(&bar[XB_TMO])) break; if (sp > XB_SPIN_CAP) { atomicAdd(&bar[XB_TMO], 1u); break; } }
    }
    nloc = mine > 0u ? mine : 1u; nx = cnt > 0u ? cnt : 1u;
}

__device__ __forceinline__ void xcd_barrier(const XcdBarrier& b) {
    asm volatile("s_waitcnt vmcnt(0)" ::: "memory");
    __syncthreads();
    if (threadIdx.x == 0) {
        unsigned* bar = b.bar;
        __builtin_amdgcn_s_waitcnt(0);
        unsigned nloc = b.st[0], nx = b.st[1];
        if (nloc == 0u) { xcd_barrier_complete(bar, b.x, nloc, nx); b.st[0] = nloc; b.st[1] = nx; }
        const unsigned old = xb_add(&bar[XB_XSUB(b.x)], 1u);
        const unsigned gen = old / nloc;
        if (old + 1u == (gen + 1u) * nloc) {
            __builtin_amdgcn_fence(__ATOMIC_RELEASE, "agent");
            asm volatile("s_waitcnt vmcnt(0)" ::: "memory");
            const unsigned og = xb_add(&bar[XB_TOP], 1u);
            const unsigned tg = og / nx;
            if (og + 1u == (tg + 1u) * nx) xb_add(&bar[XB_TOPGEN], 1u);
            else XB_SPIN(xb_ld(&bar[XB_TOPGEN]) == tg, bar);
            __builtin_amdgcn_fence(__ATOMIC_ACQUIRE, "agent");
            xb_add(&bar[XB_XGEN(b.x)], 1u);
            asm volatile("s_waitcnt vmcnt(0)" ::: "memory");
        } else {
            XB_SPIN(xb_ld(&bar[XB_XGEN(b.x)]) == gen, bar);
            __builtin_amdgcn_fence(__ATOMIC_ACQUIRE, "agent");
            asm volatile("s_waitcnt vmcnt(0)" ::: "memory");
        }
    }
    __syncthreads();
}

struct Args { const float* in[24]; float* out; unsigned char* ws; int ph_lo, ph_hi; };
enum { I_X = 0, I_P, I_GMIX, I_WIN, I_CONVW, I_CONVB, I_BI, I_BF, I_LQ1, I_LK1, I_LQ2, I_LK2, I_SUBG, I_MLG, I_WPA, I_WPB, I_WO, I_GMLP, I_WUP, I_WDOWN, I_GPLE, I_WPG, I_WPP, I_GFIN };

__global__ void __launch_bounds__(512, 2) mega_fwd(Args args) {
    extern __shared__ __attribute__((aligned(16))) unsigned char lds_raw[];
    LAS unsigned char* lds = (LAS unsigned char*)lds_raw;
    cg::grid_group grid = cg::this_grid();
    const int tid = threadIdx.x, lane = tid & 63, wid = __builtin_amdgcn_readfirstlane(tid >> 6);
    const int G = gridDim.x, gw = blockIdx.x * 8 + wid, NGW = G * 8;
    const int vblk = (G % 8 == 0) ? (int)(blockIdx.x % 8) * (G / 8) + (int)(blockIdx.x / 8) : (int)blockIdx.x;
    unsigned char* ws = args.ws; unsigned char* dob = (unsigned char*)args.out;
    const int lo = args.ph_lo, hi_ph = args.ph_hi;
#ifndef ONLY_PHASE
#define PH_EN(k) true
#else
#define PH_EN(k) ((k) == ONLY_PHASE)
#endif
#define IN(k) (PH_EN(k) && lo <= (k) && (k) < hi_ph)
#define SEAM(k) do { if (IN(k) && IN((k) + 1)) { if ((k) == 0) grid.sync(); else xcd_barrier(xbar); } } while (0)
    volatile LAS unsigned* xst = (volatile LAS unsigned*)(lds + LDS_XB);
    if (tid == 0) { xst[0] = 0u; xst[1] = 0u; }
    __syncthreads();
    XcdBarrier xbar; xbar.bar = (unsigned*)(ws + WS_CTL); xbar.x = 0; xbar.st = xst;
    if (hi_ph - lo > 1) xbar = xcd_barrier_post((unsigned*)(ws + WS_CTL), xst);
#define MISC ((bf16_t*)(ws + WS_MISC))
#define Qf ((bf16_t*)(ws + WS_QF))
#define Kf ((bf16_t*)(ws + WS_KF))
#define VtF ((bf16_t*)(ws + WS_VTF))
#define MvT ((bf16_t*)(ws + WS_MVT))
#define MERGED ((bf16_t*)(ws + WS_MERGED))
#define WIN ((bf16_t*)(ws + WS_WIN))
#define WVT ((bf16_t*)(ws + WS_WVT))
#define WPA ((bf16_t*)(ws + WS_WPA))
#define WPB ((bf16_t*)(ws + WS_WPB))
#define WO ((bf16_t*)(ws + WS_WO))
#define WPG ((bf16_t*)(ws + WS_WPG))
#define WPP ((bf16_t*)(ws + WS_WPP))
#define PB ((bf16_t*)(ws + WS_PB))
#define GATES ((float*)(ws + WS_GATES))
#define SS ((float*)(ws + WS_SS))
#define ACT ((bf16_t*)(ws + WS_ACT))
#define PP ((float*)(ws + WS_PP))
#define XB ((bf16_t*)(ws + WS_XB))
#define WUP ((bf16_t*)(ws + WS_WUP))
#define WDOWN ((bf16_t*)(ws + WS_WDOWN))
#define HB ((bf16_t*)(dob + DO_H))
#define YA ((bf16_t*)(dob + DO_YA))
#define YB ((bf16_t*)(dob + DO_YB))
#define HRAW ((bf16_t*)(dob + DO_HRAW))
#define KCT ((bf16_t*)(dob + DO_KCT))
#define QC ((bf16_t*)(ws + WS_QC))
#define KC ((bf16_t*)(ws + WS_KC))
    LAS float* scr = (LAS float*)(lds + wid * 8448);

    if (IN(0)) for (int rep = 0; rep < NREP(0); ++rep) {
        const float* w_in = args.in[I_WIN];
        transpose_job(w_in, INC, DM, 9216, nullptr, WIN, 1, scr, gw, NGW, lane);
        transpose_job(w_in, INC, DM, 2048, nullptr, WVT, 2, scr, gw, NGW, lane);
        transpose_job(args.in[I_WPA], DM, 1024, DM, nullptr, WPA, 0, scr, gw, NGW, lane);
        transpose_job(args.in[I_WPB], DM, 1024, DM, nullptr, WPB, 0, scr, gw, NGW, lane);
        transpose_job(args.in[I_WO], DM, DM, DM, nullptr, WO, 0, scr, gw, NGW, lane);
        transpose_job(args.in[I_WPG], DM, DM, DM, args.in[I_GPLE], WPG, 0, scr, gw, NGW, lane);
        transpose_job(args.in[I_WPP], DM, 256, DM, nullptr, WPP, 0, scr, gw, NGW, lane);
        { const float* p = args.in[I_P];
            for (size_t i = ((size_t)blockIdx.x * 512 + tid) * 8; i < (size_t)T * 256; i += (size_t)G * 512 * 8) { const f32x4 a = *(const f32x4*)(p + i), b = *(const f32x4*)(p + i + 4);
                u32x4 w; w.x = pkbf(a[0], a[1]); w.y = pkbf(a[2], a[3]); w.z = pkbf(b[0], b[1]); w.w = pkbf(b[2], b[3]); *(u32x4*)(PB + i) = w; }
            for (int i = blockIdx.x * 512 + tid; i < 3 * T; i += G * 512) SS[i] = 0.f; }
        __syncthreads();
        LAS float* tab = (LAS float*)lds;
        for (int idx = tid; idx < 2 * DM; idx += 512) { const int k = idx >> 1, half = idx & 1; const f32x4 v = *(const f32x4*)(w_in + (size_t)k * INC + 7168 + 4 * half);
#pragma unroll
            for (int i = 0; i < 4; ++i) tab[(4 * half + i) * DM + k] = v[i]; }
        __syncthreads();
        const float* x = args.in[I_X]; const float* gmix = args.in[I_GMIX];
        for (int row = gw; row < T; row += NGW) {
            const f32x4* xr = (const f32x4*)(x + (size_t)row * DM) + lane; f32x4 v[8]; float s = 0.f;
#pragma unroll
            for (int j = 0; j < 8; ++j) { v[j] = xr[64 * j]; s += (v[j][0] * v[j][0] + v[j][1] * v[j][1]) + (v[j][2] * v[j][2] + v[j][3] * v[j][3]); }
            const float rs = 1.0f / sqrtf(wave_sum(s) * (1.f / DM) + RMS_EPS);
#pragma unroll
            for (int j = 0; j < 8; ++j) { const f32x4 g4 = *((const f32x4*)gmix + lane + 64 * j); v[j] = v[j] * rs * g4;
                u32x2 w; w.x = pkbf(v[j][0], v[j][1]); w.y = pkbf(v[j][2], v[j][3]); *((u32x2*)(HB + (size_t)row * DM) + lane + 64 * j) = w; }
            float myg = 0.f;
#pragma unroll 1
            for (int jj = 0; jj < 8; ++jj) { float acc = 0.f;
#pragma unroll
                for (int j = 0; j < 8; ++j) { const f32x4 t4 = *((const LAS f32x4*)(tab + jj * DM) + lane + 64 * j); acc += (v[j][0] * t4[0] + v[j][1] * t4[1]) + (v[j][2] * t4[2] + v[j][3] * t4[3]); }
                acc = wave_sum(acc); if (lane == jj) myg = acc; }
            if (lane < 8) { float r;
                if (lane < 4) r = myg + args.in[I_BI][lane];
                else { const float z = myg + args.in[I_BF][lane - 4]; r = fminf(z, 0.f) - log1pf(__expf(-fabsf(z))); }
                GATES[(size_t)row * 8 + lane] = r; }
        }
        __syncthreads();
    }
    SEAM(0);
    if (IN(1)) for (int rep = 0; rep < NREP(1); ++rep) {
        { pg8::Gemm g{HB, WIN, T, 9216, DM}; pg8::StaticOrder S; S.init(T, 9216, G, (int)blockIdx.x);
          pg8::EpiInProj E{Qf, Kf, MISC, 0.125f * 1.4426950408889634f};
          pg8::gemm_phase<pg8::EpiInProj, pg8::StaticOrder, PG8_ALIGN, PG8_SP2>(lds, g, S, E); }
        { pg8::Gemm g{WVT, HB, 2048, T, DM}; pg8::StaticOrder S; S.init(2048, T, G, (int)blockIdx.x);
          pg8::EpiVT E{VtF, MvT};
          pg8::gemm_phase<pg8::EpiVT, pg8::StaticOrder, PG8_ALIGN, PG8_SP2>(lds, g, S, E); }
    }
    SEAM(1);
    if (IN(2)) {
        for (int rep = 0; rep < NREP(12); ++rep) transpose_job(args.in[I_WDOWN], DM, DFF, DM, nullptr, WDOWN, 0, scr, gw, NGW, lane);
        __syncthreads();
        for (int rep = 0; rep < NREP(2); ++rep) conv_prepass2(lds, MISC, args.in[I_CONVW], args.in[I_CONVB], QC, KC, KCT, (int)blockIdx.x, G, tid);
        __syncthreads();
    }
    SEAM(2);
    if (IN(3)) {
        for (int rep = 0; rep < NREP(3); ++rep)
        for (int u = vblk; u < 256; u += G)
            mlstm_unit(lds, QC, KC, KCT, MvT, GATES, HRAW, u >> 5, (u >> 3) & 3, u & 7, tid, wid, lane);
    }
    SEAM(3);
    if (IN(4)) {
        { const float* __restrict__ mlg = args.in[I_MLG]; const bf16_t* __restrict__ hr = HRAW; const bf16_t* __restrict__ mo = MISC + 2048; bf16_t* __restrict__ yb = YB;
          f32x4 g4[4];
#pragma unroll
          for (int hh = 0; hh < 4; ++hh) g4[hh] = *(const f32x4*)(mlg + hh * 256 + 4 * lane);
          for (int rp = gw; rp < T / 2; rp += NGW) {
            u32x2 hw[2][4], ow[2][4]; const int row = 2 * rp, row1 = 2 * rp + 1, bb = row >> 11, sq = row & 2047;
#pragma unroll
            for (int hh = 0; hh < 4; ++hh) { const int c0 = hh * 256 + 4 * lane; const size_t ho = ((size_t)((bb * 4 + hh) * 8 + (lane >> 3)) * 2048 + sq) * 32 + 4 * (lane & 7);
                hw[0][hh] = *(const u32x2*)(hr + ho); ow[0][hh] = *(const u32x2*)(mo + (size_t)row * 7168 + c0);
                hw[1][hh] = *(const u32x2*)(hr + ho + 32); ow[1][hh] = *(const u32x2*)(mo + (size_t)row1 * 7168 + c0); }
#pragma unroll
            for (int r = 0; r < 2; ++r) { const int rw = r ? row1 : row;
#pragma unroll
                for (int hh = 0; hh < 4; ++hh) { const int c0 = hh * 256 + 4 * lane;
                    const float h0 = bflo(hw[r][hh].x), h1 = bfhi(hw[r][hh].x), h2 = bflo(hw[r][hh].y), h3 = bfhi(hw[r][hh].y);
                    const float rn = 1.0f / sqrtf(wave_sum((h0 * h0 + h1 * h1) + (h2 * h2 + h3 * h3)) * (1.f / 256.f) + RMS_EPS);
                    u32x2 w; w.x = pkbf(h0 * rn * g4[hh][0] * bflo(ow[r][hh].x), h1 * rn * g4[hh][1] * bfhi(ow[r][hh].x)); w.y = pkbf(h2 * rn * g4[hh][2] * bflo(ow[r][hh].y), h3 * rn * g4[hh][3] * bfhi(ow[r][hh].y));
                    *(u32x2*)(yb + (size_t)rw * 1024 + c0) = w; } }
          } }
        float l1 = args.in[I_LQ1][lane] * args.in[I_LK1][lane], l2 = args.in[I_LQ2][lane] * args.in[I_LK2][lane];
        const float lam = expf(wave_sum(l1)) - expf(wave_sum(l2)) + 0.2f;
        __syncthreads();
        for (int rep = 0; rep < NREP(4); ++rep)
        for (int vb = vblk; vb < 256; vb += G) { const int bh = vb >> 2, pr = vb & 3;
            attn_block_unit2(lds, Qf, Kf, VtF, YA, args.in[I_SUBG], lam, bh, pr, tid, wid, lane);
            attn_block_unit2(lds, Qf, Kf, VtF, YA, args.in[I_SUBG], lam, bh, 7 - pr, tid, wid, lane); }
        __syncthreads();
    }
    SEAM(4);
    if (IN(5)) for (int rep = 0; rep < NREP(5); ++rep) {
        { pg8::Gemm g{YA, WPA, T, DM, 1024}; pg8::StaticOrder S; S.init(T, DM, G, (int)blockIdx.x);
          pg8::EpiMerge E{MERGED, MISC + 3072, 0};
          pg8::gemm_phase<pg8::EpiMerge, pg8::StaticOrder, PG8_ALIGN, PG8_SP2>(lds, g, S, E); }
        { pg8::Gemm g{YB, WPB, T, DM, 1024}; pg8::StaticOrder S; S.init(T, DM, G, (int)blockIdx.x);
          pg8::EpiMerge E{MERGED, MISC + 5120, 1};
          pg8::gemm_phase<pg8::EpiMerge, pg8::StaticOrder, PG8_ALIGN, PG8_SP2>(lds, g, S, E); }
    }
    SEAM(5);
    if (IN(6)) {
        transpose_job(args.in[I_WUP], DFF, DM, DFF, args.in[I_GMLP], WUP, 0, scr, gw, NGW, lane);
        __syncthreads();
        pg8::Gemm g{MERGED, WO, T, DM, DM}; pg8::StaticOrder S; S.init(T, DM, G, (int)blockIdx.x);
        pg8::EpiResB E{args.in[I_X], nullptr, XB, SS};
        pg8::gemm_phase<pg8::EpiResB, pg8::StaticOrder, PG8_ALIGN_HEAVY, PG8_SP2>(lds, g, S, E);
    }
    SEAM(6);
    if (IN(7)) for (int rep = 0; rep < NREP(7); ++rep) {
        pg8::Gemm g{XB, WUP, T, DFF, DM}; pg8::StaticOrder S; S.init(T, DFF, G, (int)blockIdx.x);
        pg8::EpiUp E{ACT, SS};
        pg8::gemm_phase<pg8::EpiUp, pg8::StaticOrder, PG8_ALIGN, PG8_SP2>(lds, g, S, E);
    }
    SEAM(7);
    if (IN(8)) {
        pg8::Gemm g{ACT, WDOWN, T, DM, DFF}; pg8::StaticOrder S; S.init(T, DM, G, (int)blockIdx.x);
        pg8::EpiResB E{nullptr, XB, XB, SS + T};
        pg8::gemm_phase<pg8::EpiResB, pg8::StaticOrder, PG8_ALIGN_HEAVY, PG8_SP2>(lds, g, S, E);
    }
    SEAM(8);
    if (IN(9)) {
        bf16_t* GB = (bf16_t*)(ws + WS_PP);
        { pg8::Gemm g{XB, WPG, T, DM, DM}; pg8::StaticOrder S; S.init(T, DM, G, (int)blockIdx.x);
          pg8::EpiGate E{GB, SS + T};
          pg8::gemm_phase<pg8::EpiGate, pg8::StaticOrder, PG8_ALIGN, PG8_SP2>(lds, g, S, E); }
        { int kpp = 256; asm volatile("" : "+s"(kpp)); pg8::Gemm g{PB, WPP, T, DM, kpp}; pg8::StaticOrder S; S.init(T, DM, G, (int)blockIdx.x);
          pg8::EpiPle3 E{XB, GB, SS + 2 * T};
          pg8::gemm_phase<pg8::EpiPle3, pg8::StaticOrder, PG8_ALIGN_HEAVY, PG8_SP2>(lds, g, S, E); }
    }
    SEAM(9);
    if (IN(10)) {
        const float* __restrict__ gfin = args.in[I_GFIN]; const bf16_t* __restrict__ xb = XB; float* __restrict__ outp = args.out;
        for (int row = gw; row < T; row += NGW) {
            const float rs = 1.0f / sqrtf(SS[2 * T + row] * (1.f / DM) + RMS_EPS);
            const u32x2* xr = (const u32x2*)(xb + (size_t)row * DM) + lane; f32x4* orow = (f32x4*)(outp + (size_t)row * DM) + lane;
#pragma unroll
            for (int j = 0; j < 8; ++j) { const u32x2 w = xr[64 * j]; const f32x4 g4 = *((const f32x4*)gfin + lane + 64 * j);
                f32x4 v; v[0] = bflo(w.x) * rs * g4[0]; v[1] = bfhi(w.x) * rs * g4[1]; v[2] = bflo(w.y) * rs * g4[2]; v[3] = bfhi(w.y) * rs * g4[3]; orow[64 * j] = v; }
        }
    }
#undef IN
#undef SEAM
#undef MISC
#undef Qf
#undef Kf
#undef VtF
#undef MvT
#undef MERGED
#undef WIN
#undef WVT
#undef WPA
#undef WPB
#undef WO
#undef WPG
#undef WPP
#undef PB
#undef GATES
#undef SS
#undef ACT
#undef PP
#undef XB
#undef WUP
#undef WDOWN
#undef HB
#undef YA
#undef YB
#undef HRAW
#undef KCT
#undef QC
#undef KC
}

extern "C" void kernel_launch(void* const* d_in, const int* in_sizes, int n_in, void* d_out, int out_size, void* d_ws, size_t ws_size, hipStream_t stream) {
    static int grid = 0;
    if (grid == 0) {
        if (n_in != 24 || out_size != T * DM || ws_size < WS_END) { fprintf(stderr, "kernel_launch: unexpected problem (n_in %d, out %d, ws %zu)\n", n_in, out_size, ws_size); grid = -1; return; }
        int dev = 0, cus = 0, per_cu = 0;
        if (hipGetDevice(&dev) != hipSuccess || hipDeviceGetAttribute(&cus, hipDeviceAttributeMultiprocessorCount, dev) != hipSuccess) { grid = -1; return; }
        if (hipFuncSetAttribute((const void*)mega_fwd, hipFuncAttributeMaxDynamicSharedMemorySize, LDS_BYTES) != hipSuccess) { fprintf(stderr, "kernel_launch: hipFuncSetAttribute failed\n"); grid = -1; return; }
        if (hipOccupancyMaxActiveBlocksPerMultiprocessor(&per_cu, (const void*)mega_fwd, 512, LDS_BYTES) != hipSuccess || per_cu < 1) { fprintf(stderr, "kernel_launch: occupancy query says %d\n", per_cu); (void)hipGetLastError(); grid = -1; return; }
        grid = cus;
    }
    if (grid < 0) return;
    if (hipMemsetAsync((char*)d_ws + WS_CTL, 0, CTL_BYTES, stream) != hipSuccess) { fprintf(stderr, "kernel_launch: hipMemsetAsync failed\n"); return; }
    Args a{};
    for (int i = 0; i < 24; ++i) a.in[i] = (const float*)d_in[i];
    a.out = (float*)d_out; a.ws = (unsigned char*)d_ws;
#if MK_N_LAUNCHES == 1
    a.ph_lo = 0; a.ph_hi = NPH;
    void* kargs[] = {&a};
    hipError_t e = hipLaunchCooperativeKernel((const void*)mega_fwd, dim3(grid), dim3(512), kargs, LDS_BYTES, stream);
    if (e != hipSuccess) fprintf(stderr, "kernel_launch: cooperative launch failed: %s (grid %d)\n", hipGetErrorString(e), grid);
#else
    for (int ph = 0; ph < NPH; ++ph) for (int rep = 0; rep < (ph == EXTRA_PHASE ? 2 : 1); ++rep) { a.ph_lo = ph; a.ph_hi = ph + 1; hipLaunchKernelGGL(mega_fwd, dim3(grid), dim3(512), LDS_BYTES, stream, a); }
#endif
}
```

```cpp
#include <hip/hip_runtime.h>
#include <hip/hip_cooperative_groups.h>
#include <cstdio>
#include <cstdint>
namespace cg = cooperative_groups;
namespace pg8 {
#define PG8_LAS __attribute__((address_space(3)))
typedef unsigned short bf16_t;
typedef short bf16x8 __attribute__((ext_vector_type(8)));
typedef float f32x4 __attribute__((ext_vector_type(4)));
typedef unsigned u32x4 __attribute__((ext_vector_type(4)));
constexpr int BM = 256, BK = 64, HALF = 128, HTB = HALF * BK * 2  , STAGE_BYTES = 8 * HTB, NXCD = 8, WGM = 8;

__host__ __device__ __forceinline__ int lds_byte(int r, int c) { const int st = (r >> 4) * 2 + (c >> 5), rr = r & 15, cc = c & 31, ob = rr * 64 + cc * 2; return st * 1024 + (ob ^ (((ob >> 9) & 1) << 5)); }
__host__ __device__ __forceinline__ void stage_rc(int b, int& R, int& C) { const int st = b / 1024, sb = b % 1024, swz = sb ^ (((sb >> 9) & 1) << 5); R = (st >> 1) * 16 + swz / 64; C = (st & 1) * 32 + (swz % 64) / 2; }
__host__ __device__ __forceinline__ int perm32(int rho) { const int n = rho >> 4, i = rho & 15; return 8 * (i >> 2) + 4 * n + (i & 3); }

struct Unit { int pm, pn; };
struct Gemm { const bf16_t* A; const bf16_t* Bt; int M, N, K; };

struct StaticOrder {
    int nM, nN, nwg, G, c;
    __host__ __device__ void init(int M, int N, int G_, int c_) { nM = M / BM; nN = N / BM; nwg = nM * nN; G = G_; c = c_; }
    __host__ __device__ bool next(int i, Unit& u) const {
        const long L = (long)i * G + c; if (L >= nwg) return false;
        int wgid = (int)L; { const int q = nwg / NXCD, r = nwg % NXCD, xcd = wgid % NXCD, off = wgid / NXCD; wgid = (xcd < r ? xcd * (q + 1) : r * (q + 1) + (xcd - r) * q) + off; }
        const int nig = WGM * nN, gid = wgid / nig, fm = gid * WGM, gsz = (nM - fm) < WGM ? (nM - fm) : WGM;
        u.pm = fm + ((wgid % nig) % gsz); u.pn = (wgid % nig) / gsz; return true;
    }
    __device__ __forceinline__ void a_ready(const Unit&) const {}
    __device__ __forceinline__ void done(const Unit&) const {}
};

typedef unsigned u32x2 __attribute__((ext_vector_type(2)));
typedef float f32x2v __attribute__((ext_vector_type(2)));
typedef __bf16 bf16x2v __attribute__((ext_vector_type(2)));
__device__ __forceinline__ unsigned pkbf(float lo, float hi) { f32x2v v = {lo, hi}; bf16x2v b = __builtin_convertvector(v, bf16x2v); return __builtin_bit_cast(unsigned, b); }
__device__ __forceinline__ float bflo(unsigned w) { return __uint_as_float(w << 16); }
__device__ __forceinline__ float bfhi(unsigned w) { return __uint_as_float(w & 0xffff0000u); }
__device__ __forceinline__ float sigm(float x) { return __builtin_amdgcn_rcpf(1.f + __builtin_amdgcn_exp2f(-1.4426950408889634f * x)); }
constexpr float RMS_EPS = 1e-6f;

struct EpiInProj {
    static constexpr bool PERM = true, AFTER_DRAIN = false;
    bf16_t* Qf; bf16_t* Kf; bf16_t* MISC; float qscale;
    __device__ __forceinline__ void operator()(const f32x4 (&acc)[2][2][4][2], const Unit& u, int wr, int wc, int fr, int fq) const {
        const int colt = u.pn * BM, row0 = u.pm * BM + wr * 64 + fr;
#pragma unroll
        for (int ai = 0; ai < 2; ++ai)
#pragma unroll
            for (int m = 0; m < 4; ++m) { const int row = row0 + ai * HALF + m * 16;
#pragma unroll
                for (int bj = 0; bj < 2; ++bj) { const int col = colt + bj * HALF + wc * 32 + 8 * fq;
                    f32x4 v0 = acc[ai][bj][m][0], v1 = acc[ai][bj][m][1]; bf16_t* dst;
                    if (colt < 2048) {
                        if (colt < 1024) { v0 = v0 * qscale; v1 = v1 * qscale; }
                        const int c = col & 1023, h = c >> 7, mp = (c >> 6) & 1, d = c & 63, d0 = d >> 4, hi = (d >> 3) & 1, b = row >> 11, s = row & 2047;
                        const size_t idx16 = (size_t)((((((b * 8 + h) * 2 + mp) * 64 + (s >> 5)) * 4 + d0) * 2 + hi)) * 32 + (s & 31);
                        dst = (colt < 1024 ? Qf : Kf) + idx16 * 8;
                    } else {
                        const int cc = col - 2048;
                        if (cc >= 2048) {
#pragma unroll
                            for (int i = 0; i < 4; ++i) { v0[i] = sigm(v0[i]); v1[i] = sigm(v1[i]); } }
                        dst = MISC + (size_t)row * 7168 + cc;
                    }
                    u32x4 w; w.x = pkbf(v0[0], v0[1]); w.y = pkbf(v0[2], v0[3]); w.z = pkbf(v1[0], v1[1]); w.w = pkbf(v1[2], v1[3]);
                    *(u32x4*)dst = w; } }
    }
};
struct EpiVT {
    static constexpr bool PERM = true, AFTER_DRAIN = false;
    bf16_t* VtF; bf16_t* MvT;
    __device__ __forceinline__ void operator()(const f32x4 (&acc)[2][2][4][2], const Unit& u, int wr, int wc, int fr, int fq) const {
        const int row0 = u.pm * BM + wr * 64 + fr;
#pragma unroll
        for (int ai = 0; ai < 2; ++ai)
#pragma unroll
            for (int m = 0; m < 4; ++m) { const int R = row0 + ai * HALF + m * 16;
#pragma unroll
                for (int bj = 0; bj < 2; ++bj) { const int tok0 = u.pn * BM + bj * HALF + wc * 32 + 8 * fq;
                    const f32x4 v0 = acc[ai][bj][m][0], v1 = acc[ai][bj][m][1];
                    if (u.pm < 4) {
                        const int h = R >> 7, e = R & 127, eb = e >> 5, e32 = e & 31, b = tok0 >> 11, s = tok0 & 2047, kt = s >> 5, g = (s & 31) >> 3, t = g >> 1, jb = 4 * (g & 1);
                        bf16_t* base = VtF + (size_t)(((((b * 8 + h) * 64 + kt) * 4 + eb) * 2 + t)) * 512 + e32 * 8 + jb;
                        u32x2 w0, w1; w0.x = pkbf(v0[0], v0[1]); w0.y = pkbf(v0[2], v0[3]); w1.x = pkbf(v1[0], v1[1]); w1.y = pkbf(v1[2], v1[3]);
                        *(u32x2*)base = w0; *(u32x2*)(base + 256) = w1;
                    } else {
                        u32x4 w; w.x = pkbf(v0[0], v0[1]); w.y = pkbf(v0[2], v0[3]); w.z = pkbf(v1[0], v1[1]); w.w = pkbf(v1[2], v1[3]);
                        *(u32x4*)(MvT + (size_t)(R - 1024) * 16384 + tok0) = w;
                    } } }
    }
};
struct EpiMerge {
    static constexpr bool PERM = true, AFTER_DRAIN = false;
    bf16_t* O; const bf16_t* G; int second;
    __device__ __forceinline__ void operator()(const f32x4 (&acc)[2][2][4][2], const Unit& u, int wr, int wc, int fr, int fq) const {
        const int row0 = u.pm * BM + wr * 64 + fr;
#pragma unroll
        for (int ai = 0; ai < 2; ++ai)
#pragma unroll
            for (int m = 0; m < 4; ++m) { const int row = row0 + ai * HALF + m * 16;
#pragma unroll
                for (int bj = 0; bj < 2; ++bj) { const int col = u.pn * BM + bj * HALF + wc * 32 + 8 * fq;
                    f32x4 v0 = acc[ai][bj][m][0], v1 = acc[ai][bj][m][1];
                    const u32x4 g = *(const u32x4*)(G + (size_t)row * 7168 + col);
                    v0[0] *= bflo(g.x); v0[1] *= bfhi(g.x); v0[2] *= bflo(g.y); v0[3] *= bfhi(g.y); v1[0] *= bflo(g.z); v1[1] *= bfhi(g.z); v1[2] *= bflo(g.w); v1[3] *= bfhi(g.w);
                    bf16_t* dst = O + (size_t)row * 2048 + col;
                    if (second) { const u32x4 p = *(const u32x4*)dst;
                        v0[0] += bflo(p.x); v0[1] += bfhi(p.x); v0[2] += bflo(p.y); v0[3] += bfhi(p.y); v1[0] += bflo(p.z); v1[1] += bfhi(p.z); v1[2] += bflo(p.w); v1[3] += bfhi(p.w); }
                    u32x4 w; w.x = pkbf(v0[0], v0[1]); w.y = pkbf(v0[2], v0[3]); w.z = pkbf(v1[0], v1[1]); w.w = pkbf(v1[2], v1[3]);
                    *(u32x4*)dst = w; } }
    }
};
struct EpiUp {
    static constexpr bool PERM = true, AFTER_DRAIN = false;
    bf16_t* O; const float* ssq;
    __device__ __forceinline__ void operator()(const f32x4 (&acc)[2][2][4][2], const Unit& u, int wr, int wc, int fr, int fq) const {
        const int row0 = u.pm * BM + wr * 64 + fr;
#pragma unroll
        for (int ai = 0; ai < 2; ++ai)
#pragma unroll
            for (int m = 0; m < 4; ++m) { const int row = row0 + ai * HALF + m * 16; const float rs = __builtin_amdgcn_rsqf(ssq[row] * (1.f / 2048.f) + RMS_EPS);
#pragma unroll
                for (int bj = 0; bj < 2; ++bj) { const int col = u.pn * BM + bj * HALF + wc * 32 + 8 * fq;
                    f32x4 v0 = acc[ai][bj][m][0] * rs, v1 = acc[ai][bj][m][1] * rs;
#pragma unroll
                    for (int i = 0; i < 4; ++i) { const float a = fmaxf(v0[i], 0.f), b = fmaxf(v1[i], 0.f); v0[i] = a * a; v1[i] = b * b; }
                    u32x4 w; w.x = pkbf(v0[0], v0[1]); w.y = pkbf(v0[2], v0[3]); w.z = pkbf(v1[0], v1[1]); w.w = pkbf(v1[2], v1[3]);
                    *(u32x4*)(O + (size_t)row * 8192 + col) = w; } }
    }
};
struct EpiGate {
    static constexpr bool PERM = true, AFTER_DRAIN = false;
    bf16_t* O; const float* ssq;
    __device__ __forceinline__ void operator()(const f32x4 (&acc)[2][2][4][2], const Unit& u, int wr, int wc, int fr, int fq) const {
        const int row0 = u.pm * BM + wr * 64 + fr;
#pragma unroll
        for (int ai = 0; ai < 2; ++ai)
#pragma unroll
            for (int m = 0; m < 4; ++m) { const int row = row0 + ai * HALF + m * 16; const float rs = __builtin_amdgcn_rsqf(ssq[row] * (1.f / 2048.f) + RMS_EPS);
#pragma unroll
                for (int bj = 0; bj < 2; ++bj) { const int col = u.pn * BM + bj * HALF + wc * 32 + 8 * fq;
                    f32x4 v0 = acc[ai][bj][m][0] * rs, v1 = acc[ai][bj][m][1] * rs;
#pragma unroll
                    for (int i = 0; i < 4; ++i) { v0[i] = sigm(v0[i]); v1[i] = sigm(v1[i]); }
                    u32x4 w; w.x = pkbf(v0[0], v0[1]); w.y = pkbf(v0[2], v0[3]); w.z = pkbf(v1[0], v1[1]); w.w = pkbf(v1[2], v1[3]);
                    *(u32x4*)(O + (size_t)row * 2048 + col) = w; } }
    }
};

struct EpiResB {
    static constexpr bool PERM = true, AFTER_DRAIN = false;
    const float* basef; const bf16_t* baseb; bf16_t* outb; float* ssq;
    __device__ __forceinline__ void operator()(const f32x4 (&acc)[2][2][4][2], const Unit& u, int wr, int wc, int fr, int fq) const {
        const int row0 = u.pm * BM + wr * 64 + fr;
#pragma unroll
        for (int ai = 0; ai < 2; ++ai)
#pragma unroll
            for (int m = 0; m < 4; ++m) { const int row = row0 + ai * HALF + m * 16; float s = 0.f;
#pragma unroll
                for (int bj = 0; bj < 2; ++bj) { const size_t c = (size_t)row * 2048 + u.pn * BM + bj * HALF + wc * 32 + 8 * fq;
                    f32x4 v0 = acc[ai][bj][m][0], v1 = acc[ai][bj][m][1];
                    if (basef) { v0 += *(const f32x4*)(basef + c); v1 += *(const f32x4*)(basef + c + 4); }
                    else { const u32x4 b = *(const u32x4*)(baseb + c);
                        v0[0] += bflo(b.x); v0[1] += bfhi(b.x); v0[2] += bflo(b.y); v0[3] += bfhi(b.y); v1[0] += bflo(b.z); v1[1] += bfhi(b.z); v1[2] += bflo(b.w); v1[3] += bfhi(b.w); }
                    s += ((v0[0] * v0[0] + v0[1] * v0[1]) + (v0[2] * v0[2] + v0[3] * v0[3])) + ((v1[0] * v1[0] + v1[1] * v1[1]) + (v1[2] * v1[2] + v1[3] * v1[3]));
                    u32x4 w; w.x = pkbf(v0[0], v0[1]); w.y = pkbf(v0[2], v0[3]); w.z = pkbf(v1[0], v1[1]); w.w = pkbf(v1[2], v1[3]);
                    *(u32x4*)(outb + c) = w; }
                s += __shfl_xor(s, 16); s += __shfl_xor(s, 32);
                if (fq == 0) atomicAdd(ssq + row, s);
                asm volatile("" ::: "memory"); }
    }
};
struct EpiPle3 {
    static constexpr bool PERM = true, AFTER_DRAIN = false;
    bf16_t* xb; const bf16_t* g; float* ssq_out;
    __device__ __forceinline__ void operator()(const f32x4 (&acc)[2][2][4][2], const Unit& u, int wr, int wc, int fr, int fq) const {
        const int row0 = u.pm * BM + wr * 64 + fr;
#pragma unroll
        for (int ai = 0; ai < 2; ++ai)
#pragma unroll
            for (int m = 0; m < 4; ++m) { const int row = row0 + ai * HALF + m * 16; float s = 0.f;
#pragma unroll
                for (int bj = 0; bj < 2; ++bj) { const size_t c = (size_t)row * 2048 + u.pn * BM + bj * HALF + wc * 32 + 8 * fq;
                    const f32x4 a0 = acc[ai][bj][m][0], a1 = acc[ai][bj][m][1]; const u32x4 b = *(const u32x4*)(xb + c), gw = *(const u32x4*)(g + c);
                    f32x4 v0, v1;
                    v0[0] = bflo(b.x) + bflo(gw.x) * a0[0]; v0[1] = bfhi(b.x) + bfhi(gw.x) * a0[1]; v0[2] = bflo(b.y) + bflo(gw.y) * a0[2]; v0[3] = bfhi(b.y) + bfhi(gw.y) * a0[3];
                    v1[0] = bflo(b.z) + bflo(gw.z) * a1[0]; v1[1] = bfhi(b.z) + bfhi(gw.z) * a1[1]; v1[2] = bflo(b.w) + bflo(gw.w) * a1[2]; v1[3] = bfhi(b.w) + bfhi(gw.w) * a1[3];
                    s += ((v0[0] * v0[0] + v0[1] * v0[1]) + (v0[2] * v0[2] + v0[3] * v0[3])) + ((v1[0] * v1[0] + v1[1] * v1[1]) + (v1[2] * v1[2] + v1[3] * v1[3]));
                    u32x4 w; w.x = pkbf(v0[0], v0[1]); w.y = pkbf(v0[2], v0[3]); w.z = pkbf(v1[0], v1[1]); w.w = pkbf(v1[2], v1[3]);
                    *(u32x4*)(xb + c) = w; }
                s += __shfl_xor(s, 16); s += __shfl_xor(s, 32);
                if (fq == 0) atomicAdd(ssq_out + row, s);
                asm volatile("" ::: "memory"); }
    }
};


template <class Epi, class Sched, bool ALIGN_EPI = false, bool SP2 = false>
__device__ __forceinline__ void gemm_phase(PG8_LAS unsigned char* lds, const Gemm g, const Sched& S, const Epi& E) {
    const int tid = threadIdx.x, wid = __builtin_amdgcn_readfirstlane(tid >> 6), lane = tid & 63, wr = wid >> 2, wc = wid & 3, fr = lane & 15, fq = lane >> 4;
    const int K = g.K, nt = K / BK;
    unsigned voffA[2], voffB[2];
#pragma unroll
    for (int i = 0; i < 2; ++i) { int R, C; stage_rc(tid * 16 + i * 8192, R, C); const int Rb = Epi::PERM ? ((R & ~31) + perm32(R & 31)) : R;
        voffA[i] = (unsigned)(R * K + C) * 2u; voffB[i] = (unsigned)(Rb * K + C) * 2u; }
    const size_t kstep = (size_t)(BK * 2);
    const size_t hstep = (size_t)HALF * K * 2;
    const size_t tstep = 2 * hstep;
    const unsigned ldsw = (unsigned)wid * 1024u;
    const int aoff = lds_byte(wr * 64 + fr, fq * 8), boff = lds_byte(wc * 32 + fr, fq * 8);
#define PG8_SA(b, h) (((b) * 2 + (h)) * HTB)
#define PG8_SB(b, h) ((4 + (b) * 2 + (h)) * HTB)
#define PG8_STAGE(bufoff, gbase, voff) do { _Pragma("unroll") for (int _i = 0; _i < 2; ++_i) \
        __builtin_amdgcn_global_load_lds((const unsigned*)((const char*)(gbase) + (voff)[_i]), (PG8_LAS unsigned*)(lds + (bufoff) + ldsw + _i * 8192), 16, 0, 0); } while (0)
#define PG8_LDA(dst, b, h) do { _Pragma("unroll") for (int m = 0; m < 4; ++m) _Pragma("unroll") for (int k = 0; k < 2; ++k) dst[m][k] = *(const PG8_LAS bf16x8*)(lds + PG8_SA(b, h) + aoff + m * 2048 + k * 1024); } while (0)
#define PG8_LDB(dst, b, h) do { _Pragma("unroll") for (int n = 0; n < 2; ++n) _Pragma("unroll") for (int k = 0; k < 2; ++k) dst[n][k] = *(const PG8_LAS bf16x8*)(lds + PG8_SB(b, h) + boff + n * 2048 + k * 1024); } while (0)
#define PG8_MMA(ai, bj, At, Bt) do { __builtin_amdgcn_s_setprio(1); _Pragma("unroll") for (int m = 0; m < 4; ++m) _Pragma("unroll") for (int n = 0; n < 2; ++n) _Pragma("unroll") for (int k = 0; k < 2; ++k) \
        acc[ai][bj][m][n] = __builtin_amdgcn_mfma_f32_16x16x32_bf16(Bt[n][k], At[m][k], acc[ai][bj][m][n], 0, 0, 0); __builtin_amdgcn_s_setprio(0); } while (0)
#define PG8_WAIT_V(n) asm volatile("s_waitcnt vmcnt(" #n ")" ::: "memory")
#define PG8_WAIT_L(n) asm volatile("s_waitcnt lgkmcnt(" #n ")" ::: "memory")
#define PG8_BAR __builtin_amdgcn_s_barrier()
#define PG8_SCHED __builtin_amdgcn_sched_barrier(0)
    Unit cur, nxt; int ui = 0;
    if (!S.next(0, cur)) return;
    f32x4 acc[2][2][4][2];
#pragma unroll
    for (int a = 0; a < 2; ++a)
#pragma unroll
        for (int b = 0; b < 2; ++b)
#pragma unroll
            for (int m = 0; m < 4; ++m)
#pragma unroll
                for (int n = 0; n < 2; ++n) acc[a][b][m][n] = (f32x4){0.f, 0.f, 0.f, 0.f};
    bf16x8 At[4][2], B0[2][2], B1[2][2];
    const char* cA = (const char*)g.A + (size_t)cur.pm * tstep; const char* cB = (const char*)g.Bt + (size_t)cur.pn * tstep;
    S.a_ready(cur);
    if constexpr (SP2) {
        PG8_STAGE(PG8_SB(0, 0), cB, voffB); PG8_STAGE(PG8_SB(0, 1), cB + hstep, voffB); PG8_STAGE(PG8_SA(0, 0), cA, voffA); PG8_STAGE(PG8_SA(0, 1), cA + hstep, voffA);
        if (wr == 1) PG8_BAR;
        PG8_WAIT_V(2); PG8_BAR;
        PG8_STAGE(PG8_SB(1, 0), cB + kstep, voffB); PG8_STAGE(PG8_SA(1, 0), cA + kstep, voffA); PG8_STAGE(PG8_SB(1, 1), cB + hstep + kstep, voffB);
        PG8_WAIT_V(6); PG8_BAR;
    } else {
        PG8_STAGE(PG8_SB(0, 0), cB, voffB); PG8_STAGE(PG8_SA(0, 0), cA, voffA); PG8_STAGE(PG8_SB(0, 1), cB + hstep, voffB); PG8_STAGE(PG8_SA(0, 1), cA + hstep, voffA);
        if (wr == 1) PG8_BAR;
        PG8_WAIT_V(4); PG8_BAR;
        PG8_STAGE(PG8_SB(1, 0), cB + kstep, voffB); PG8_STAGE(PG8_SA(1, 0), cA + kstep, voffA); PG8_STAGE(PG8_SB(1, 1), cB + hstep + kstep, voffB);
        PG8_WAIT_V(6); PG8_BAR;
    }
    for (;;) {
        const bool has_next = S.next(ui + 1, nxt);
        const char* nA = has_next ? (const char*)g.A + (size_t)nxt.pm * tstep : cA; const char* nB = has_next ? (const char*)g.Bt + (size_t)nxt.pn * tstep : cB;
        for (int t = 0; t < nt; t += 2) {
            const bool last = (t == nt - 2);
            const char* a1 = cA + (size_t)(t + 1) * kstep;
            const char* a2 = last ? nA : cA + (size_t)(t + 2) * kstep; const char* b2 = last ? nB : cB + (size_t)(t + 2) * kstep;
            const char* a3 = a2 + kstep; const char* b3 = b2 + kstep;
            if (last && has_next) S.a_ready(nxt);
            if constexpr (SP2) {
            PG8_LDB(B0, 0, 0); PG8_LDB(B1, 0, 1); PG8_SCHED; PG8_LDA(At, 0, 0); PG8_STAGE(PG8_SA(1, 1), a1 + hstep, voffA);
            PG8_WAIT_V(8); PG8_WAIT_L(0); PG8_BAR; PG8_MMA(0, 0, At, B0); PG8_MMA(0, 1, At, B1); PG8_BAR; PG8_SCHED;
            PG8_LDA(At, 0, 1); PG8_STAGE(PG8_SB(0, 0), b2, voffB); PG8_STAGE(PG8_SB(0, 1), b2 + hstep, voffB); PG8_STAGE(PG8_SA(0, 0), a2, voffA);
            PG8_WAIT_V(8); PG8_WAIT_L(0); PG8_BAR; PG8_MMA(1, 0, At, B0); PG8_MMA(1, 1, At, B1); PG8_BAR; PG8_SCHED;
            PG8_LDB(B0, 1, 0); PG8_LDB(B1, 1, 1); PG8_SCHED; PG8_LDA(At, 1, 0); PG8_STAGE(PG8_SA(0, 1), a2 + hstep, voffA);
            PG8_WAIT_V(8); PG8_WAIT_L(0); PG8_BAR; PG8_MMA(0, 0, At, B0); PG8_MMA(0, 1, At, B1); PG8_BAR; PG8_SCHED;
            PG8_LDA(At, 1, 1); PG8_STAGE(PG8_SB(1, 0), b3, voffB); PG8_STAGE(PG8_SB(1, 1), b3 + hstep, voffB); PG8_STAGE(PG8_SA(1, 0), a3, voffA);
            PG8_WAIT_V(8); PG8_WAIT_L(0); PG8_BAR; PG8_MMA(1, 0, At, B0); PG8_MMA(1, 1, At, B1); PG8_BAR; PG8_SCHED;
            } else {
            PG8_LDB(B0, 0, 0); PG8_SCHED; PG8_LDA(At, 0, 0); PG8_STAGE(PG8_SA(1, 1), a1 + hstep, voffA);
            PG8_WAIT_L(8); PG8_BAR; PG8_WAIT_L(0); PG8_MMA(0, 0, At, B0); PG8_BAR; PG8_SCHED;
            PG8_LDB(B1, 0, 1); PG8_STAGE(PG8_SB(0, 0), b2, voffB);
            PG8_BAR; PG8_WAIT_L(0); PG8_MMA(0, 1, At, B1); PG8_BAR;
            PG8_LDA(At, 0, 1); PG8_STAGE(PG8_SA(0, 0), a2, voffA);
            PG8_BAR; PG8_WAIT_L(0); PG8_MMA(1, 0, At, B0); PG8_BAR; PG8_SCHED;
            PG8_STAGE(PG8_SB(0, 1), b2 + hstep, voffB);
            PG8_WAIT_V(6); PG8_BAR; PG8_MMA(1, 1, At, B1); PG8_BAR;
            PG8_LDB(B0, 1, 0); PG8_SCHED; PG8_LDA(At, 1, 0); PG8_STAGE(PG8_SA(0, 1), a2 + hstep, voffA);
            PG8_WAIT_L(8); PG8_BAR; PG8_WAIT_L(0); PG8_MMA(0, 0, At, B0); PG8_BAR; PG8_SCHED;
            PG8_LDB(B1, 1, 1); PG8_STAGE(PG8_SB(1, 0), b3, voffB);
            PG8_BAR; PG8_WAIT_L(0); PG8_MMA(0, 1, At, B1); PG8_BAR;
            PG8_LDA(At, 1, 1); PG8_STAGE(PG8_SA(1, 0), a3, voffA);
            PG8_BAR; PG8_WAIT_L(0); PG8_MMA(1, 0, At, B0); PG8_BAR; PG8_SCHED;
            PG8_STAGE(PG8_SB(1, 1), b3 + hstep, voffB);
            PG8_WAIT_V(6); PG8_BAR; PG8_MMA(1, 1, At, B1); PG8_BAR;
            }
        }
        if constexpr (ALIGN_EPI) { if (wr == 0) PG8_BAR; }
        if constexpr (!Epi::AFTER_DRAIN) { E(acc, cur, wr, wc, fr, fq); S.done(cur); }
        if (!has_next) break;
#pragma unroll
        for (int a = 0; a < 2; ++a)
#pragma unroll
            for (int b = 0; b < 2; ++b)
#pragma unroll
                for (int m = 0; m < 4; ++m)
#pragma unroll
                    for (int n = 0; n < 2; ++n) acc[a][b][m][n] = (f32x4){0.f, 0.f, 0.f, 0.f};
        cur = nxt; cA = nA; cB = nB; ++ui;
        if constexpr (ALIGN_EPI) { if (wr == 1) PG8_BAR; }
    }
    PG8_WAIT_V(0);
    if constexpr (!ALIGN_EPI) { if (wr == 0) PG8_BAR; }
    PG8_BAR;
    if constexpr (Epi::AFTER_DRAIN) { E.fused(acc, cur, wr, wc, fr, fq, lds, wid, lane); S.done(cur); }
#undef PG8_SA
#undef PG8_SB
#undef PG8_STAGE
#undef PG8_LDA
#undef PG8_LDB
#undef PG8_MMA
#undef PG8_WAIT_V
#undef PG8_WAIT_L
#undef PG8_BAR
#undef PG8_SCHED
}
}

#ifndef PG8_SP2
#define PG8_SP2 true
#endif
#ifndef PG8_ALIGN
#define PG8_ALIGN true
#endif
#ifndef REPEAT_PHASE
#define REPEAT_PHASE -1
#endif
#define NREP(k) ((k) == REPEAT_PHASE ? 2 : 1)
#ifndef EXTRA_PHASE
#define EXTRA_PHASE -1
#endif
#ifndef PG8_ALIGN_HEAVY
#define PG8_ALIGN_HEAVY true
#endif
#ifndef MK_N_LAUNCHES
#define MK_N_LAUNCHES 1
#endif
#define LAS __attribute__((address_space(3)))
using pg8::bf16_t; using pg8::bf16x8; using pg8::f32x4; using pg8::u32x4; using pg8::u32x2; using pg8::pkbf; using pg8::bflo; using pg8::bfhi; using pg8::sigm; using pg8::RMS_EPS;
typedef float f32x16 __attribute__((ext_vector_type(16)));
#define MFMA32(a, b, c) __builtin_amdgcn_mfma_f32_32x32x16_bf16((a), (b), (c), 0, 0, 0)
#define MFMA16(a, b, c) __builtin_amdgcn_mfma_f32_16x16x32_bf16((a), (b), (c), 0, 0, 0)

constexpr int T = 16384, DM = 2048, DFF = 8192, INC = 11272, NPH = 11;
constexpr size_t MiB = (size_t)1 << 20;
constexpr size_t WS_MISC = 0, WS_QF = 224 * MiB, WS_KF = 256 * MiB, WS_VTF = 288 * MiB, WS_MVT = 320 * MiB, WS_MERGED = 352 * MiB;
constexpr size_t WS_WIN = 416 * MiB, WS_WVT = 452 * MiB, WS_WPA = 460 * MiB, WS_WPB = 464 * MiB, WS_WO = 468 * MiB, WS_WPG = 476 * MiB, WS_WPP = 484 * MiB, WS_PB = 485 * MiB;
constexpr size_t WS_GATES = 493 * MiB, WS_SS = 494 * MiB, WS_CTL = 496 * MiB, CTL_BYTES = 16384, WS_END = 497 * MiB;
constexpr int LDS_XB = 147392;
constexpr size_t WS_ACT = 0, WS_PP = 0, WS_XB = 256 * MiB, WS_WUP = 320 * MiB, WS_WDOWN = 416 * MiB;
constexpr size_t DO_H = 0, DO_YA = 0, DO_YB = 32 * MiB, DO_HRAW = 64 * MiB, DO_KCT = 96 * MiB;
constexpr size_t WS_QC = 352 * MiB, WS_KC = 384 * MiB;
constexpr int LDS_BYTES = 147456;

__device__ __forceinline__ float wave_sum(float v) {
#pragma unroll
    for (int o = 1; o < 64; o <<= 1) v += __shfl_xor(v, o);
    return v;
}
#define LDS_WAIT() asm volatile("s_waitcnt lgkmcnt(0)" ::: "memory")

__device__ __forceinline__ void transpose_item(const float* W, int ldw, int K, int srccol, const float* gain, bf16_t* WT, int n0, int k0, LAS float* scr, int lane) {
#pragma unroll 8
    for (int i = 0; i < 32; ++i) { const int kk = 2 * i + (lane >> 5); float v = W[(size_t)(k0 + kk) * ldw + srccol + (lane & 31)]; if (gain) v *= gain[k0 + kk]; scr[kk * 33 + (lane & 31)] = v; }
    LDS_WAIT();
    const int c = lane & 7;
#pragma unroll
    for (int j = 0; j < 4; ++j) { const int n = (lane >> 3) + 8 * j; const LAS float* s = scr + (8 * c) * 33 + n;
        u32x4 o; o.x = pkbf(s[0 * 33], s[1 * 33]); o.y = pkbf(s[2 * 33], s[3 * 33]); o.z = pkbf(s[4 * 33], s[5 * 33]); o.w = pkbf(s[6 * 33], s[7 * 33]);
        *(u32x4*)(WT + (size_t)(n0 + n) * K + k0 + 8 * c) = o; }
    LDS_WAIT();
}
__device__ __forceinline__ void transpose_job(const float* W, int ldw, int K, int N, const float* gain, bf16_t* WT, int mode, LAS float* scr, int gw, int NGW, int lane) {
    const int nblk = N / 32, items = (K / 64) * nblk;
    for (int it = gw; it < items; it += NGW) {
        const int kb = it / nblk, nb = it % nblk, n0 = 32 * nb;
        int src = n0;
        if (mode == 1) src = n0 < 2048 ? n0 : (n0 < 4096 ? n0 + 1024 : (n0 < 5120 ? n0 + 2048 : n0 + 2056));
        if (mode == 2) src = n0 < 1024 ? n0 + 2048 : n0 + 4096;
        transpose_item(W, ldw, K, src, gain, WT, n0, 64 * kb, scr, lane);
    }
}

__device__ __forceinline__ void attn_block_unit2(LAS unsigned char* lds, const bf16_t* __restrict__ Qf, const bf16_t* __restrict__ Kf, const bf16_t* __restrict__ VtF, bf16_t* __restrict__ ya, const float* __restrict__ subg, float lam,
                                                 int bh, int j, int tid, int wid, int lane) {
    const int r32 = lane & 31, hi = lane >> 5, qg = 8 * j + wid, nst = 4 * j + 4, myst = 4 * j + (wid >> 1) + 1;
    const int foff = hi * 512 + r32 * 16;
    LAS unsigned* park = (LAS unsigned*)(lds + 49152 + wid * 8192) + lane;
    const bf16_t* gv = VtF + (size_t)(bh * 64) * 4096 + tid * 8;
    f32x16 o[4];
#pragma unroll 1
    for (int mp = 0; mp < 2; ++mp) {
        bf16x8 q[4];
#pragma unroll
        for (int d0 = 0; d0 < 4; ++d0) q[d0] = *(const bf16x8*)(Qf + ((size_t)(((((bh * 2 + mp) * 64 + qg) * 4 + d0) * 2 + hi)) * 32 + r32) * 8);
        const bf16_t* gk = Kf + (size_t)((bh * 2 + mp) * 64) * 2048 + tid * 8;
        o[0] = f32x16{}; o[1] = f32x16{}; o[2] = f32x16{}; o[3] = f32x16{};
        float mrun = -INFINITY, lrun = 0.f;
        u32x4 pk = *(const u32x4*)gk, pv0 = *(const u32x4*)gv, pv1 = *(const u32x4*)(gv + 4096);
        *(LAS u32x4*)(lds + tid * 16) = pk; *(LAS u32x4*)(lds + 8192 + tid * 16) = pv0; *(LAS u32x4*)(lds + 16384 + tid * 16) = pv1;
        __syncthreads();
        for (int st = 0; st < nst; ++st) {
            LAS unsigned char* buf = lds + (st & 1) * 24576; LAS unsigned char* nbuf = lds + ((st + 1) & 1) * 24576;
            if (st + 1 < nst) { pk = *(const u32x4*)(gk + (size_t)(st + 1) * 4096); pv0 = *(const u32x4*)(gv + (size_t)(st + 1) * 8192); pv1 = *(const u32x4*)(gv + (size_t)(st + 1) * 8192 + 4096); }
            if (st < myst) {
#pragma unroll
                for (int u = 0; u < 2; ++u) {
                    f32x16 sc = {};
#pragma unroll
                    for (int d0 = 0; d0 < 4; ++d0) { const bf16x8 kf = *(const LAS bf16x8*)(buf + u * 4096 + d0 * 1024 + foff); sc = MFMA32(kf, q[d0], sc); }
                    float t = sc[0];
#pragma unroll
                    for (int r = 1; r < 16; ++r) t = fmaxf(t, sc[r]);
                    t = fmaxf(t, __shfl_xor(t, 32));
                    const float n = fmaxf(mrun, t);
                    if (__any(n > mrun)) { const float al = __builtin_amdgcn_exp2f(mrun - n); lrun *= al;
#pragma unroll
                        for (int eb = 0; eb < 4; ++eb)
#pragma unroll
                            for (int r = 0; r < 16; ++r) o[eb][r] *= al;
                        mrun = n; }
                    float p[16], e = 0.f;
#pragma unroll
                    for (int r = 0; r < 16; ++r) { p[r] = __builtin_amdgcn_exp2f(sc[r] - mrun); e += p[r]; }
                    lrun += e;
                    u32x4 w0, w1; w0.x = pkbf(p[0], p[1]); w0.y = pkbf(p[2], p[3]); w0.z = pkbf(p[4], p[5]); w0.w = pkbf(p[6], p[7]);
                    w1.x = pkbf(p[8], p[9]); w1.y = pkbf(p[10], p[11]); w1.z = pkbf(p[12], p[13]); w1.w = pkbf(p[14], p[15]);
                    const bf16x8 pf0 = __builtin_bit_cast(bf16x8, w0), pf1 = __builtin_bit_cast(bf16x8, w1);
#pragma unroll
                    for (int eb = 0; eb < 4; ++eb) { const bf16x8 v0 = *(const LAS bf16x8*)(buf + 8192 + u * 8192 + (eb * 2 + 0) * 1024 + foff), v1 = *(const LAS bf16x8*)(buf + 8192 + u * 8192 + (eb * 2 + 1) * 1024 + foff);
                        o[eb] = MFMA32(v0, pf0, o[eb]); o[eb] = MFMA32(v1, pf1, o[eb]); }
                }
            }
            if (st + 1 < nst) { *(LAS u32x4*)(nbuf + tid * 16) = pk; *(LAS u32x4*)(nbuf + 8192 + tid * 16) = pv0; *(LAS u32x4*)(nbuf + 16384 + tid * 16) = pv1; }
            __syncthreads();
        }
        lrun += __shfl_xor(lrun, 32);
        if (mp == 0) { const float il = 1.f / lrun;
#pragma unroll
            for (int eb = 0; eb < 4; ++eb)
#pragma unroll
                for (int r = 0; r < 16; r += 2) park[(eb * 8 + (r >> 1)) * 64] = pkbf(o[eb][r] * il, o[eb][r + 1] * il);
        } else { const float c2 = -lam / lrun;
#pragma unroll
            for (int eb = 0; eb < 4; ++eb)
#pragma unroll
                for (int r = 0; r < 16; r += 2) { const unsigned w = park[(eb * 8 + (r >> 1)) * 64]; o[eb][r] = bflo(w) + c2 * o[eb][r]; o[eb][r + 1] = bfhi(w) + c2 * o[eb][r + 1]; }
        }
    }
    float ss = 0.f;
#pragma unroll
    for (int eb = 0; eb < 4; ++eb)
#pragma unroll
        for (int r = 0; r < 16; ++r) ss += o[eb][r] * o[eb][r];
    ss += __shfl_xor(ss, 32);
    const float rn = __builtin_amdgcn_rsqf(ss * (1.f / 128.f) + RMS_EPS) * 0.8f;
    const int b = bh >> 3, h = bh & 7;
    bf16_t* dst = ya + (size_t)(b * 2048 + qg * 32 + r32) * 1024 + h * 128;
#pragma unroll
    for (int eb = 0; eb < 4; ++eb)
#pragma unroll
        for (int g = 0; g < 4; ++g) { const int e0 = 32 * eb + 8 * g + 4 * hi; const f32x4 gg = *(const f32x4*)(subg + e0);
            u32x2 w; w.x = pkbf(o[eb][4 * g] * rn * gg[0], o[eb][4 * g + 1] * rn * gg[1]); w.y = pkbf(o[eb][4 * g + 2] * rn * gg[2], o[eb][4 * g + 3] * rn * gg[3]);
            *(u32x2*)(dst + e0) = w; }
}

__device__ __forceinline__ void conv_prepass2(LAS unsigned char* lds, const bf16_t* __restrict__ MISC_, const float* __restrict__ conv_w, const float* __restrict__ conv_b, bf16_t* __restrict__ QC_, bf16_t* __restrict__ KC_, bf16_t* __restrict__ KCT_,
                                              int blk, int nblk, int tid) {
    constexpr int TPK = 72;
    LAS bf16_t* tile = (LAS bf16_t*)lds;
    const int cpl = tid & 255, th = tid >> 8;
    for (int it = blk; it < 1024; it += nblk) {
        const int cg_ = it & 3, tb = it >> 2, ch = cg_ * 512 + 2 * cpl, trow0 = tb * 64 + th * 32; const bool isk = cg_ >= 2, seqstart = (trow0 & 2047) == 0;
        const bf16_t* src = MISC_ + (size_t)trow0 * 7168 + ch;
        float cw0[4], cw1[4];
#pragma unroll
        for (int j = 0; j < 4; ++j) { cw0[j] = conv_w[j * 2048 + ch]; cw1[j] = conv_w[j * 2048 + ch + 1]; }
        const float cb0 = conv_b[ch], cb1 = conv_b[ch + 1], osc = isk ? 1.f : 0.0625f;
        bf16_t* dst = (isk ? KC_ : QC_) + (size_t)trow0 * 1024 + (ch & 1023);
        float xa[3], xb[3];
#pragma unroll
        for (int j = 0; j < 3; ++j) { unsigned w = 0u; if (!seqstart) w = *(const unsigned*)(src - (size_t)(3 - j) * 7168); xa[j] = bflo(w); xb[j] = bfhi(w); }
#pragma unroll
        for (int g = 0; g < 4; ++g) {
            float ya_[8], yb_[8];
#pragma unroll
            for (int i = 0; i < 8; ++i) { const int tt = g * 8 + i;
                const unsigned w = *(const unsigned*)(src + (size_t)tt * 7168); const float x0 = bflo(w), x1 = bfhi(w);
                float y0 = cb0 + cw0[0] * xa[0] + cw0[1] * xa[1] + cw0[2] * xa[2] + cw0[3] * x0;
                float y1 = cb1 + cw1[0] * xb[0] + cw1[1] * xb[1] + cw1[2] * xb[2] + cw1[3] * x1;
                xa[0] = xa[1]; xa[1] = xa[2]; xa[2] = x0; xb[0] = xb[1]; xb[1] = xb[2]; xb[2] = x1;
                y0 = y0 * sigm(y0) * osc; y1 = y1 * sigm(y1) * osc; ya_[i] = y0; yb_[i] = y1;
                *(unsigned*)(dst + (size_t)tt * 1024) = pkbf(y0, y1); }
            if (isk) {
                u32x4 wa, wb; wa.x = pkbf(ya_[0], ya_[1]); wa.y = pkbf(ya_[2], ya_[3]); wa.z = pkbf(ya_[4], ya_[5]); wa.w = pkbf(ya_[6], ya_[7]);
                wb.x = pkbf(yb_[0], yb_[1]); wb.y = pkbf(yb_[2], yb_[3]); wb.z = pkbf(yb_[4], yb_[5]); wb.w = pkbf(yb_[6], yb_[7]);
                *(LAS u32x4*)(tile + (2 * cpl) * TPK + th * 32 + g * 8) = wa; *(LAS u32x4*)(tile + (2 * cpl + 1) * TPK + th * 32 + g * 8) = wb; }
        }
        if (isk) {
            __syncthreads();
#pragma unroll
            for (int i = 0; i < 8; ++i) { const int idx = tid + 512 * i, row = idx >> 3, seg = idx & 7;
                *(u32x4*)(KCT_ + (size_t)((cg_ - 2) * 512 + row) * 16384 + tb * 64 + 8 * seg) = *(const LAS u32x4*)(tile + row * TPK + 8 * seg); }
            __syncthreads();
        }
    }
}

__device__ __forceinline__ void mlstm_unit(LAS unsigned char* lds, const bf16_t* __restrict__ QC, const bf16_t* __restrict__ KC, const bf16_t* __restrict__ KCT, const bf16_t* __restrict__ MvT, const float* __restrict__ gates,
                                           bf16_t* __restrict__ hraw, int b, int hh, int es, int tid, int wid, int lane) {
    constexpr int QP = 264, TP = 72;
    LAS bf16_t* qs = (LAS bf16_t*)(lds);
    LAS bf16_t* ks = (LAS bf16_t*)(lds + 33792);
    LAS bf16_t* kT = (LAS bf16_t*)(lds + 67584);
    LAS bf16_t* Cb = (LAS bf16_t*)(lds + 104448);
    LAS bf16_t* Sb = (LAS bf16_t*)(lds + 121344);
    LAS float* nvec = (LAS float*)(lds + 130560);
    LAS float* aS = (LAS float*)(lds + 132608);
    LAS float* ML = aS + 64; LAS float* IW = aS + 128; LAS float* EM = aS + 192; LAS float* WS = aS + 256;
    LAS bf16_t* Vs = (LAS bf16_t*)(lds + 134144);
    LAS bf16_t* Vw = (LAS bf16_t*)(lds + 138752);
    LAS bf16_t* nb16 = (LAS bf16_t*)(lds + 143360);
    const int r32 = lane & 31, hi = lane >> 5, r16 = lane & 15, kq = lane >> 4, lt = wid >> 1, et = wid & 1;
    f32x16 C = {};
    if (tid < 256) { nvec[tid] = 0.f; nb16[tid] = 0; }
    float m_prev = 0.f;
    const bf16_t* qsrc = QC + (size_t)(b * 2048) * 1024 + hh * 256;
    const bf16_t* ksrc = KC + (size_t)(b * 2048) * 1024 + hh * 256;
    const bf16_t* ktsrc = KCT + (size_t)(hh * 256) * 16384 + b * 2048;
    const float* gsrc = gates + (size_t)(b * 2048 + lane) * 8 + hh;
    const bf16_t* vsrc = MvT + (size_t)(hh * 256 + es * 32 + (tid >> 4)) * 16384 + b * 2048 + 4 * (tid & 15);
    u32x4 pq[4], pk[4], pt[4]; float pli, plf; u32x2 pv;
#define ML_PREFETCH(cc) do { \
        _Pragma("unroll") for (int i = 0; i < 4; ++i) { const int idx = tid + 512 * i; \
            pq[i] = *(const u32x4*)(qsrc + (size_t)((cc) * 64 + (idx >> 5)) * 1024 + 8 * (idx & 31)); pk[i] = *(const u32x4*)(ksrc + (size_t)((cc) * 64 + (idx >> 5)) * 1024 + 8 * (idx & 31)); \
            } \
        pli = gsrc[(size_t)(cc) * 512]; plf = gsrc[(size_t)(cc) * 512 + 4]; } while (0)
#define ML_PREFETCH2(cc) do { \
        _Pragma("unroll") for (int i = 0; i < 4; ++i) { const int idx = tid + 512 * i; pt[i] = *(const u32x4*)(ktsrc + (size_t)(idx >> 3) * 16384 + (cc) * 64 + 8 * (idx & 7)); } \
        pv = *(const u32x2*)(vsrc + (cc) * 64); } while (0)
    ML_PREFETCH(0); ML_PREFETCH2(0);
    for (int c = 0; c < 32; ++c) {
        const int t0 = b * 2048 + c * 64;
        LAS float* nv_cur = nvec + (c & 1) * 256; LAS float* nv_nxt = nvec + ((c + 1) & 1) * 256;
        LAS bf16_t* nb_cur = nb16 + (c & 1) * 256; LAS bf16_t* nb_nxt = nb16 + ((c + 1) & 1) * 256;
        const float li = pli, lf = plf;
        float bc = lf;
#pragma unroll
        for (int o = 1; o < 64; o <<= 1) { const float v = __shfl_up(bc, o); if (lane >= o) bc += v; }
        const float a = li - bc; float A = a;
#pragma unroll
        for (int o = 1; o < 64; o <<= 1) { const float v = __shfl_up(A, o); if (lane >= o) A = fmaxf(A, v); }
        const float Mx = fmaxf(m_prev, A), iw = __expf(m_prev - Mx), em = __expf(-(bc + Mx));
        const float M63 = fmaxf(m_prev, __shfl(A, 63)), wsv = __expf(a - M63), decay = __expf(m_prev - M63), m_new = __shfl(bc, 63) + M63;
        if (wid == 0) { aS[lane] = a; ML[lane] = Mx; IW[lane] = iw; EM[lane] = em; WS[lane] = wsv; }
#pragma unroll
        for (int i = 0; i < 4; ++i) { const int idx = tid + 512 * i;
            *(LAS u32x4*)(qs + (idx >> 5) * QP + 8 * (idx & 31)) = pq[i]; *(LAS u32x4*)(ks + (idx >> 5) * QP + 8 * (idx & 31)) = pk[i]; *(LAS u32x4*)(kT + (idx >> 3) * TP + 8 * (idx & 7)) = pt[i]; }
        { const int sb = 4 * (tid & 15);
            *(LAS u32x2*)(Vs + (tid >> 4) * TP + sb) = pv;
            u32x2 sv; sv.x = pkbf(bflo(pv.x) * __shfl(wsv, sb), bfhi(pv.x) * __shfl(wsv, sb + 1)); sv.y = pkbf(bflo(pv.y) * __shfl(wsv, sb + 2), bfhi(pv.y) * __shfl(wsv, sb + 3));
            *(LAS u32x2*)(Vw + (tid >> 4) * TP + sb) = sv; }
        if (c + 1 < 32) ML_PREFETCH(c + 1);
        __syncthreads();
#pragma unroll
        for (int sti = 0; sti < 2; ++sti) { const int st = 2 * (wid & 1) + sti; f32x4 g4 = {0.f, 0.f, 0.f, 0.f};
            if (st <= lt) {
#pragma unroll
                for (int kb = 0; kb < 8; ++kb) { const bf16x8 af = *(const LAS bf16x8*)(qs + (16 * lt + r16) * QP + 32 * kb + 8 * kq), bf = *(const LAS bf16x8*)(ks + (16 * st + r16) * QP + 32 * kb + 8 * kq);
                    g4 = MFMA16(af, bf, g4); if (kb & 1) __builtin_amdgcn_sched_barrier(0); } }
            __builtin_amdgcn_sched_barrier(0);
            const int s = 16 * st + r16; const float as = aS[s];
#pragma unroll
            for (int r = 0; r < 4; ++r) { const int l = 16 * lt + 4 * kq + r; const float v = (s <= l) ? g4[r] * __expf(fminf(as - ML[l], 0.f)) : 0.f;
                Sb[l * TP + s] = (bf16_t)(pkbf(v, 0.f) & 0xffffu); } }
#pragma unroll
        for (int g = 0; g < 4; ++g) { u32x2 w; w.x = pkbf(C[4 * g], C[4 * g + 1]); w.y = pkbf(C[4 * g + 2], C[4 * g + 3]); *(LAS u32x2*)(Cb + r32 * QP + 32 * wid + 8 * g + 4 * hi) = w; }
        __syncthreads();
        f32x4 nm = {0.f, 0.f, 0.f, 0.f}, dn = {0.f, 0.f, 0.f, 0.f};
        const unsigned msk = (r16 == 0) ? 0xFFFFFFFFu : 0u;
#pragma unroll
        for (int kb = 0; kb < 8; ++kb) { const bf16x8 af = *(const LAS bf16x8*)(qs + (16 * lt + r16) * QP + 32 * kb + 8 * kq), bf = *(const LAS bf16x8*)(Cb + (16 * et + r16) * QP + 32 * kb + 8 * kq);
            u32x4 nw = *(const LAS u32x4*)(nb_cur + 32 * kb + 8 * kq); nw.x &= msk; nw.y &= msk; nw.z &= msk; nw.w &= msk; const bf16x8 nf = __builtin_bit_cast(bf16x8, nw);
            nm = MFMA16(af, bf, nm); dn = MFMA16(af, nf, dn); if (kb & 1) __builtin_amdgcn_sched_barrier(0); }
        __builtin_amdgcn_sched_barrier(0);
#pragma unroll
        for (int r = 0; r < 4; ++r) { const float w = IW[16 * lt + 4 * kq + r]; nm[r] *= w; dn[r] *= w; }
#pragma unroll
        for (int kb = 0; kb < 2; ++kb) { const bf16x8 af = *(const LAS bf16x8*)(Sb + (16 * lt + r16) * TP + 32 * kb + 8 * kq), bf = *(const LAS bf16x8*)(Vs + (16 * et + r16) * TP + 32 * kb + 8 * kq);
            u32x4 ow; ow.x = 0x3F803F80u & msk; ow.y = ow.x; ow.z = ow.x; ow.w = ow.x;
            nm = MFMA16(af, bf, nm); dn = MFMA16(af, __builtin_bit_cast(bf16x8, ow), dn); }
#pragma unroll
        for (int r = 0; r < 4; ++r) { const int l = 16 * lt + 4 * kq + r; const float dnv = fmaxf(fabsf(__shfl(dn[r], kq * 16)), EM[l]); const float hv = nm[r] / dnv;
            hraw[((size_t)((b * 4 + hh) * 8 + es) * 2048 + (c * 64 + l)) * 32 + 16 * et + r16] = (bf16_t)(pkbf(hv, 0.f) & 0xffffu); }
        if (c + 1 < 32) ML_PREFETCH2(c + 1);
#pragma unroll
        for (int i = 0; i < 16; ++i) C[i] *= decay;
#pragma unroll
        for (int kb = 0; kb < 4; ++kb) { const bf16x8 af = *(const LAS bf16x8*)(kT + (32 * wid + r32) * TP + 16 * kb + 8 * hi);
            const bf16x8 sv = *(const LAS bf16x8*)(Vw + r32 * TP + 16 * kb + 8 * hi);
            C = MFMA32(af, sv, C); __builtin_amdgcn_sched_barrier(0); }
        { const int d = tid >> 1, half = tid & 1; float sacc = 0.f;
#pragma unroll
            for (int i = 0; i < 4; ++i) { const u32x4 kw = *(const LAS u32x4*)(kT + d * TP + 32 * half + 8 * i); const f32x4 w0 = *(const LAS f32x4*)(WS + 32 * half + 8 * i), w1 = *(const LAS f32x4*)(WS + 32 * half + 8 * i + 4);
                sacc += bflo(kw.x) * w0[0] + bfhi(kw.x) * w0[1] + bflo(kw.y) * w0[2] + bfhi(kw.y) * w0[3] + bflo(kw.z) * w1[0] + bfhi(kw.z) * w1[1] + bflo(kw.w) * w1[2] + bfhi(kw.w) * w1[3];
                if (i & 1) __builtin_amdgcn_sched_barrier(0); }
            sacc += __shfl_xor(sacc, 1);
            if (half == 0) { const float nn = decay * nv_cur[d] + sacc; nv_nxt[d] = nn; nb_nxt[d] = (bf16_t)(pkbf(nn, 0.f) & 0xffffu); } }
        m_prev = m_new;
        __syncthreads();
    }
#undef ML_PREFETCH
#undef ML_PREFETCH2
}

#define XB_TMO      128
#define XB_XCNT(j)  (256  + 64 * (j))
#define XB_XSUB(j)  (1280 + 64 * (j))
#define XB_XGEN(j)  (2304 + 64 * (j))
#define XB_TOP      3328
#define XB_TOPGEN   3392
#define XCD_BAR_WORDS 3456
#define XB_SPIN_CAP (1u << 18)

__device__ __forceinline__ unsigned xb_ld(unsigned* p)              { return __hip_atomic_load(p, __ATOMIC_RELAXED, __HIP_MEMORY_SCOPE_AGENT); }
__device__ __forceinline__ unsigned xb_add(unsigned* p, unsigned v) { return __hip_atomic_fetch_add(p, v, __ATOMIC_RELAXED, __HIP_MEMORY_SCOPE_AGENT); }
__device__ __forceinline__ unsigned xb_xcc_id() { return (unsigned)__builtin_amdgcn_s_getreg((3 << 11) | 20) & 0xFu; }
#define XB_SPIN(cond, bar) do { unsigned _sp = 0; while (cond) { __builtin_amdgcn_s_sleep(1); \
    if ((++_sp & 255u) == 0u) { if (xb_ld(&(bar)[XB_TMO])) break; if (_sp > XB_SPIN_CAP) { atomicAdd(&(bar)[XB_TMO], 1u); break; } } } } while (0)

struct XcdBarrier {
    unsigned* bar; unsigned x;
    volatile LAS unsigned* st;
};

__device__ __forceinline__ XcdBarrier xcd_barrier_post(unsigned* bar, volatile LAS unsigned* st) {
    XcdBarrier b; b.bar = bar; b.x = xb_xcc_id(); b.st = st;
    if (threadIdx.x == 0) (void)xb_add(&bar[XB_XCNT(b.x)], 1u);
    return b;
}
__device__ __forceinline__ void xcd_barrier_complete(unsigned* bar, unsigned x, unsigned& nloc, unsigned& nx) {
    const unsigned G = gridDim.x * gridDim.y * gridDim.z;
    unsigned sum, cnt, mine, sp = 0u;
    for (;;) {
        sum = 0u; cnt = 0u; mine = 0u;
#pragma unroll
        for (unsigned j = 0; j < 16; ++j) { const unsigned c = xb_ld(&bar[XB_XCNT(j)]); sum += c; cnt += (c > 0u) ? 1u : 0u; mine = (j == x) ? c : mine; }
        if (sum == G) break;
        __builtin_amdgcn_s_sleep(1);
        if ((++sp & 255u) == 0u) { if (xb_ld(&bar[XB_TMO])) break; if (sp > XB_SPIN_CAP) { atomicAdd(&bar[XB_TMO], 1u); break; } }
    }
    nloc = mine > 0u ? mine : 1u; nx = cnt > 0u ? cnt : 1u;
}

__device__ __forceinline__ void xcd_barrier(const XcdBarrier& b) {
    asm volatile("s_waitcnt vmcnt(0)" ::: "memory");
    __syncthreads();
    if (threadIdx.x == 0) {
        unsigned* bar = b.bar;
        __builtin_amdgcn_s_waitcnt(0);
        unsigned nloc = b.st[0], nx = b.st[1];
        if (nloc == 0u) { xcd_barrier_complete(bar, b.x, nloc, nx); b.st[0] = nloc; b.st[1] = nx; }
        const unsigned old = xb_add(&bar[XB_XSUB(b.x)], 1u);
        const unsigned gen = old / nloc;
        if (old + 1u == (gen + 1u) * nloc) {
            __builtin_amdgcn_fence(__ATOMIC_RELEASE, "agent");
            asm volatile("s_waitcnt vmcnt(0)" ::: "memory");
            const unsigned og = xb_add(&bar[XB_TOP], 1u);
            const unsigned tg = og / nx;
            if (og + 1u == (tg + 1u) * nx) xb_add(&bar[XB_TOPGEN], 1u);
            else XB_SPIN(xb_ld(&bar[XB_TOPGEN]) == tg, bar);
            __builtin_amdgcn_fence(__ATOMIC_ACQUIRE, "agent");
            xb_add(&bar[XB_XGEN(b.x)], 1u);
            asm volatile("s_waitcnt vmcnt(0)" ::: "memory");
        } else {
            XB_SPIN(xb_ld(&bar[XB_XGEN(b.x)]) == gen, bar);
            __builtin_amdgcn_fence(__ATOMIC_ACQUIRE, "agent");
            asm volatile("s_waitcnt vmcnt(0)" ::: "memory");
        }
    }
    __syncthreads();
}

struct Args { const float* in[24]; float* out; unsigned char* ws; int ph_lo, ph_hi; };
enum { I_X = 0, I_P, I_GMIX, I_WIN, I_CONVW, I_CONVB, I_BI, I_BF, I_LQ1, I_LK1, I_LQ2, I_LK2, I_SUBG, I_MLG, I_WPA, I_WPB, I_WO, I_GMLP, I_WUP, I_WDOWN, I_GPLE, I_WPG, I_WPP, I_GFIN };

__global__ void __launch_bounds__(512, 2) mega_fwd(Args args) {
    extern __shared__ __attribute__((aligned(16))) unsigned char lds_raw[];
    LAS unsigned char* lds = (LAS unsigned char*)lds_raw;
    cg::grid_group grid = cg::this_grid();
    const int tid = threadIdx.x, lane = tid & 63, wid = __builtin_amdgcn_readfirstlane(tid >> 6);
    const int G = gridDim.x, gw = blockIdx.x * 8 + wid, NGW = G * 8;
    const int vblk = (G % 8 == 0) ? (int)(blockIdx.x % 8) * (G / 8) + (int)(blockIdx.x / 8) : (int)blockIdx.x;
    unsigned char* ws = args.ws; unsigned char* dob = (unsigned char*)args.out;
    const int lo = args.ph_lo, hi_ph = args.ph_hi;
#ifndef ONLY_PHASE
#define PH_EN(k) true
#else
#define PH_EN(k) ((k) == ONLY_PHASE)
#endif
#define IN(k) (PH_EN(k) && lo <= (k) && (k) < hi_ph)
#define SEAM(k) do { if (IN(k) && IN((k) + 1)) { if ((k) == 0) { grid.sync(); xbar = xcd_barrier_post((unsigned*)(ws + WS_CTL), xst); } else xcd_barrier(xbar); } } while (0)
    volatile LAS unsigned* xst = (volatile LAS unsigned*)(lds + LDS_XB);
    if (tid == 0) { xst[0] = 0u; xst[1] = 0u; }
    __syncthreads();
    XcdBarrier xbar; xbar.bar = (unsigned*)(ws + WS_CTL); xbar.x = 0; xbar.st = xst;
#define MISC ((bf16_t*)(ws + WS_MISC))
#define Qf ((bf16_t*)(ws + WS_QF))
#define Kf ((bf16_t*)(ws + WS_KF))
#define VtF ((bf16_t*)(ws + WS_VTF))
#define MvT ((bf16_t*)(ws + WS_MVT))
#define MERGED ((bf16_t*)(ws + WS_MERGED))
#define WIN ((bf16_t*)(ws + WS_WIN))
#define WVT ((bf16_t*)(ws + WS_WVT))
#define WPA ((bf16_t*)(ws + WS_WPA))
#define WPB ((bf16_t*)(ws + WS_WPB))
#define WO ((bf16_t*)(ws + WS_WO))
#define WPG ((bf16_t*)(ws + WS_WPG))
#define WPP ((bf16_t*)(ws + WS_WPP))
#define PB ((bf16_t*)(ws + WS_PB))
#define GATES ((float*)(ws + WS_GATES))
#define SS ((float*)(ws + WS_SS))
#define ACT ((bf16_t*)(ws + WS_ACT))
#define PP ((float*)(ws + WS_PP))
#define XB ((bf16_t*)(ws + WS_XB))
#define WUP ((bf16_t*)(ws + WS_WUP))
#define WDOWN ((bf16_t*)(ws + WS_WDOWN))
#define HB ((bf16_t*)(dob + DO_H))
#define YA ((bf16_t*)(dob + DO_YA))
#define YB ((bf16_t*)(dob + DO_YB))
#define HRAW ((bf16_t*)(dob + DO_HRAW))
#define KCT ((bf16_t*)(dob + DO_KCT))
#define QC ((bf16_t*)(ws + WS_QC))
#define KC ((bf16_t*)(ws + WS_KC))
    LAS float* scr = (LAS float*)(lds + wid * 8448);

    if (IN(0)) for (int rep = 0; rep < NREP(0); ++rep) {
        if (blockIdx.x == 0) for (int i = tid; i < XCD_BAR_WORDS; i += 512) ((unsigned*)(ws + WS_CTL))[i] = 0u;
        const float* w_in = args.in[I_WIN];
        transpose_job(w_in, INC, DM, 9216, nullptr, WIN, 1, scr, gw, NGW, lane);
        transpose_job(w_in, INC, DM, 2048, nullptr, WVT, 2, scr, gw, NGW, lane);
        transpose_job(args.in[I_WPA], DM, 1024, DM, nullptr, WPA, 0, scr, gw, NGW, lane);
        transpose_job(args.in[I_WPB], DM, 1024, DM, nullptr, WPB, 0, scr, gw, NGW, lane);
        transpose_job(args.in[I_WO], DM, DM, DM, nullptr, WO, 0, scr, gw, NGW, lane);
        transpose_job(args.in[I_WPG], DM, DM, DM, args.in[I_GPLE], WPG, 0, scr, gw, NGW, lane);
        transpose_job(args.in[I_WPP], DM, 256, DM, nullptr, WPP, 0, scr, gw, NGW, lane);
        { const float* p = args.in[I_P];
            for (size_t i = ((size_t)blockIdx.x * 512 + tid) * 8; i < (size_t)T * 256; i += (size_t)G * 512 * 8) { const f32x4 a = *(const f32x4*)(p + i), b = *(const f32x4*)(p + i + 4);
                u32x4 w; w.x = pkbf(a[0], a[1]); w.y = pkbf(a[2], a[3]); w.z = pkbf(b[0], b[1]); w.w = pkbf(b[2], b[3]); *(u32x4*)(PB + i) = w; }
            for (int i = blockIdx.x * 512 + tid; i < 3 * T; i += G * 512) SS[i] = 0.f; }
        __syncthreads();
        LAS float* tab = (LAS float*)lds;
        for (int idx = tid; idx < 2 * DM; idx += 512) { const int k = idx >> 1, half = idx & 1; const f32x4 v = *(const f32x4*)(w_in + (size_t)k * INC + 7168 + 4 * half);
#pragma unroll
            for (int i = 0; i < 4; ++i) tab[(4 * half + i) * DM + k] = v[i]; }
        __syncthreads();
        const float* x = args.in[I_X]; const float* gmix = args.in[I_GMIX];
        for (int row = gw; row < T; row += NGW) {
            const f32x4* xr = (const f32x4*)(x + (size_t)row * DM) + lane; f32x4 v[8]; float s = 0.f;
#pragma unroll
            for (int j = 0; j < 8; ++j) { v[j] = xr[64 * j]; s += (v[j][0] * v[j][0] + v[j][1] * v[j][1]) + (v[j][2] * v[j][2] + v[j][3] * v[j][3]); }
            const float rs = 1.0f / sqrtf(wave_sum(s) * (1.f / DM) + RMS_EPS);
#pragma unroll
            for (int j = 0; j < 8; ++j) { const f32x4 g4 = *((const f32x4*)gmix + lane + 64 * j); v[j] = v[j] * rs * g4;
                u32x2 w; w.x = pkbf(v[j][0], v[j][1]); w.y = pkbf(v[j][2], v[j][3]); *((u32x2*)(HB + (size_t)row * DM) + lane + 64 * j) = w; }
            float myg = 0.f;
#pragma unroll 1
            for (int jj = 0; jj < 8; ++jj) { float acc = 0.f;
#pragma unroll
                for (int j = 0; j < 8; ++j) { const f32x4 t4 = *((const LAS f32x4*)(tab + jj * DM) + lane + 64 * j); acc += (v[j][0] * t4[0] + v[j][1] * t4[1]) + (v[j][2] * t4[2] + v[j][3] * t4[3]); }
                acc = wave_sum(acc); if (lane == jj) myg = acc; }
            if (lane < 8) { float r;
                if (lane < 4) r = myg + args.in[I_BI][lane];
                else { const float z = myg + args.in[I_BF][lane - 4]; r = fminf(z, 0.f) - log1pf(__expf(-fabsf(z))); }
                GATES[(size_t)row * 8 + lane] = r; }
        }
        __syncthreads();
    }
    SEAM(0);
    if (IN(1)) for (int rep = 0; rep < NREP(1); ++rep) {
        { pg8::Gemm g{HB, WIN, T, 9216, DM}; pg8::StaticOrder S; S.init(T, 9216, G, (int)blockIdx.x);
          pg8::EpiInProj E{Qf, Kf, MISC, 0.125f * 1.4426950408889634f};
          pg8::gemm_phase<pg8::EpiInProj, pg8::StaticOrder, PG8_ALIGN, PG8_SP2>(lds, g, S, E); }
        { pg8::Gemm g{WVT, HB, 2048, T, DM}; pg8::StaticOrder S; S.init(2048, T, G, (int)blockIdx.x);
          pg8::EpiVT E{VtF, MvT};
          pg8::gemm_phase<pg8::EpiVT, pg8::StaticOrder, PG8_ALIGN, PG8_SP2>(lds, g, S, E); }
    }
    SEAM(1);
    if (IN(2)) {
        for (int rep = 0; rep < NREP(12); ++rep) transpose_job(args.in[I_WDOWN], DM, DFF, DM, nullptr, WDOWN, 0, scr, gw, NGW, lane);
        __syncthreads();
        for (int rep = 0; rep < NREP(2); ++rep) conv_prepass2(lds, MISC, args.in[I_CONVW], args.in[I_CONVB], QC, KC, KCT, (int)blockIdx.x, G, tid);
        __syncthreads();
    }
    SEAM(2);
    if (IN(3)) {
        for (int rep = 0; rep < NREP(3); ++rep)
        for (int u = vblk; u < 256; u += G)
            mlstm_unit(lds, QC, KC, KCT, MvT, GATES, HRAW, u >> 5, (u >> 3) & 3, u & 7, tid, wid, lane);
    }
    SEAM(3);
    if (IN(4)) {
        { const float* __restrict__ mlg = args.in[I_MLG]; const bf16_t* __restrict__ hr = HRAW; const bf16_t* __restrict__ mo = MISC + 2048; bf16_t* __restrict__ yb = YB;
          f32x4 g4[4];
#pragma unroll
          for (int hh = 0; hh < 4; ++hh) g4[hh] = *(const f32x4*)(mlg + hh * 256 + 4 * lane);
          for (int rp = gw; rp < T / 2; rp += NGW) {
            u32x2 hw[2][4], ow[2][4]; const int row = 2 * rp, row1 = 2 * rp + 1, bb = row >> 11, sq = row & 2047;
#pragma unroll
            for (int hh = 0; hh < 4; ++hh) { const int c0 = hh * 256 + 4 * lane; const size_t ho = ((size_t)((bb * 4 + hh) * 8 + (lane >> 3)) * 2048 + sq) * 32 + 4 * (lane & 7);
                hw[0][hh] = *(const u32x2*)(hr + ho); ow[0][hh] = *(const u32x2*)(mo + (size_t)row * 7168 + c0);
                hw[1][hh] = *(const u32x2*)(hr + ho + 32); ow[1][hh] = *(const u32x2*)(mo + (size_t)row1 * 7168 + c0); }
#pragma unroll
            for (int r = 0; r < 2; ++r) { const int rw = r ? row1 : row;
#pragma unroll
                for (int hh = 0; hh < 4; ++hh) { const int c0 = hh * 256 + 4 * lane;
                    const float h0 = bflo(hw[r][hh].x), h1 = bfhi(hw[r][hh].x), h2 = bflo(hw[r][hh].y), h3 = bfhi(hw[r][hh].y);
                    const float rn = 1.0f / sqrtf(wave_sum((h0 * h0 + h1 * h1) + (h2 * h2 + h3 * h3)) * (1.f / 256.f) + RMS_EPS);
                    u32x2 w; w.x = pkbf(h0 * rn * g4[hh][0] * bflo(ow[r][hh].x), h1 * rn * g4[hh][1] * bfhi(ow[r][hh].x)); w.y = pkbf(h2 * rn * g4[hh][2] * bflo(ow[r][hh].y), h3 * rn * g4[hh][3] * bfhi(ow[r][hh].y));
                    *(u32x2*)(yb + (size_t)rw * 1024 + c0) = w; } }
          } }
        float l1 = args.in[I_LQ1][lane] * args.in[I_LK1][lane], l2 = args.in[I_LQ2][lane] * args.in[I_LK2][lane];
        const float lam = expf(wave_sum(l1)) - expf(wave_sum(l2)) + 0.2f;
        __syncthreads();
        for (int rep = 0; rep < NREP(4); ++rep)
        for (int vb = vblk; vb < 256; vb += G) { const int bh = vb >> 2, pr = vb & 3;
            attn_block_unit2(lds, Qf, Kf, VtF, YA, args.in[I_SUBG], lam, bh, pr, tid, wid, lane);
            attn_block_unit2(lds, Qf, Kf, VtF, YA, args.in[I_SUBG], lam, bh, 7 - pr, tid, wid, lane); }
        __syncthreads();
    }
    SEAM(4);
    if (IN(5)) for (int rep = 0; rep < NREP(5); ++rep) {
        { pg8::Gemm g{YA, WPA, T, DM, 1024}; pg8::StaticOrder S; S.init(T, DM, G, (int)blockIdx.x);
          pg8::EpiMerge E{MERGED, MISC + 3072, 0};
          pg8::gemm_phase<pg8::EpiMerge, pg8::StaticOrder, PG8_ALIGN, PG8_SP2>(lds, g, S, E); }
        { pg8::Gemm g{YB, WPB, T, DM, 1024}; pg8::StaticOrder S; S.init(T, DM, G, (int)blockIdx.x);
          pg8::EpiMerge E{MERGED, MISC + 5120, 1};
          pg8::gemm_phase<pg8::EpiMerge, pg8::StaticOrder, PG8_ALIGN, PG8_SP2>(lds, g, S, E); }
    }
    SEAM(5);
    if (IN(6)) {
        transpose_job(args.in[I_WUP], DFF, DM, DFF, args.in[I_GMLP], WUP, 0, scr, gw, NGW, lane);
        __syncthreads();
        pg8::Gemm g{MERGED, WO, T, DM, DM}; pg8::StaticOrder S; S.init(T, DM, G, (int)blockIdx.x);
        pg8::EpiResB E{args.in[I_X], nullptr, XB, SS};
        pg8::gemm_phase<pg8::EpiResB, pg8::StaticOrder, PG8_ALIGN_HEAVY, PG8_SP2>(lds, g, S, E);
    }
    SEAM(6);
    if (IN(7)) for (int rep = 0; rep < NREP(7); ++rep) {
        pg8::Gemm g{XB, WUP, T, DFF, DM}; pg8::StaticOrder S; S.init(T, DFF, G, (int)blockIdx.x);
        pg8::EpiUp E{ACT, SS};
        pg8::gemm_phase<pg8::EpiUp, pg8::StaticOrder, PG8_ALIGN, PG8_SP2>(lds, g, S, E);
    }
    SEAM(7);
    if (IN(8)) {
        pg8::Gemm g{ACT, WDOWN, T, DM, DFF}; pg8::StaticOrder S; S.init(T, DM, G, (int)blockIdx.x);
        pg8::EpiResB E{nullptr, XB, XB, SS + T};
        pg8::gemm_phase<pg8::EpiResB, pg8::StaticOrder, PG8_ALIGN_HEAVY, PG8_SP2>(lds, g, S, E);
    }
    SEAM(8);
    if (IN(9)) {
        bf16_t* GB = (bf16_t*)(ws + WS_PP);
        { pg8::Gemm g{XB, WPG, T, DM, DM}; pg8::StaticOrder S; S.init(T, DM, G, (int)blockIdx.x);
          pg8::EpiGate E{GB, SS + T};
          pg8::gemm_phase<pg8::EpiGate, pg8::StaticOrder, PG8_ALIGN, PG8_SP2>(lds, g, S, E); }
        { int kpp = 256; asm volatile("" : "+s"(kpp)); pg8::Gemm g{PB, WPP, T, DM, kpp}; pg8::StaticOrder S; S.init(T, DM, G, (int)blockIdx.x);
          pg8::EpiPle3 E{XB, GB, SS + 2 * T};
          pg8::gemm_phase<pg8::EpiPle3, pg8::StaticOrder, PG8_ALIGN_HEAVY, PG8_SP2>(lds, g, S, E); }
    }
    SEAM(9);
    if (IN(10)) {
        const float* __restrict__ gfin = args.in[I_GFIN]; const bf16_t* __restrict__ xb = XB; float* __restrict__ outp = args.out;
        for (int row = gw; row < T; row += NGW) {
            const float rs = 1.0f / sqrtf(SS[2 * T + row] * (1.f / DM) + RMS_EPS);
            const u32x2* xr = (const u32x2*)(xb + (size_t)row * DM) + lane; f32x4* orow = (f32x4*)(outp + (size_t)row * DM) + lane;
#pragma unroll
            for (int j = 0; j < 8; ++j) { const u32x2 w = xr[64 * j]; const f32x4 g4 = *((const f32x4*)gfin + lane + 64 * j);
                f32x4 v; v[0] = bflo(w.x) * rs * g4[0]; v[1] = bfhi(w.x) * rs * g4[1]; v[2] = bflo(w.y) * rs * g4[2]; v[3] = bfhi(w.y) * rs * g4[3]; orow[64 * j] = v; }
        }
    }
#undef IN
#undef SEAM
#undef MISC
#undef Qf
#undef Kf
#undef VtF
#undef MvT
#undef MERGED
#undef WIN
#undef WVT
#undef WPA
#undef WPB
#undef WO
#undef WPG
#undef WPP
#undef PB
#undef GATES
#undef SS
#undef ACT
#undef PP
#undef XB
#undef WUP
#undef WDOWN
#undef HB
#undef YA
#undef YB
#undef HRAW
#undef KCT
#undef QC
#undef KC
}

extern "C" void kernel_launch(void* const* d_in, const int* in_sizes, int n_in, void* d_out, int out_size, void* d_ws, size_t ws_size, hipStream_t stream) {
    static int grid = 0;
    if (grid == 0) {
        if (n_in != 24 || out_size != T * DM || ws_size < WS_END) { fprintf(stderr, "kernel_launch: unexpected problem (n_in %d, out %d, ws %zu)\n", n_in, out_size, ws_size); grid = -1; return; }
        int dev = 0, cus = 0, per_cu = 0;
        if (hipGetDevice(&dev) != hipSuccess || hipDeviceGetAttribute(&cus, hipDeviceAttributeMultiprocessorCount, dev) != hipSuccess) { grid = -1; return; }
        if (hipFuncSetAttribute((const void*)mega_fwd, hipFuncAttributeMaxDynamicSharedMemorySize, LDS_BYTES) != hipSuccess) { fprintf(stderr, "kernel_launch: hipFuncSetAttribute failed\n"); grid = -1; return; }
        if (hipOccupancyMaxActiveBlocksPerMultiprocessor(&per_cu, (const void*)mega_fwd, 512, LDS_BYTES) != hipSuccess || per_cu < 1) { fprintf(stderr, "kernel_launch: occupancy query says %d\n", per_cu); (void)hipGetLastError(); grid = -1; return; }
        grid = cus;
    }
    if (grid < 0) return;
    Args a{};
    for (int i = 0; i < 24; ++i) a.in[i] = (const float*)d_in[i];
    a.out = (float*)d_out; a.ws = (unsigned char*)d_ws;
#if MK_N_LAUNCHES == 1
    a.ph_lo = 0; a.ph_hi = NPH;
    void* kargs[] = {&a};
    hipError_t e = hipLaunchCooperativeKernel((const void*)mega_fwd, dim3(grid), dim3(512), kargs, LDS_BYTES, stream);
    if (e != hipSuccess) fprintf(stderr, "kernel_launch: cooperative launch failed: %s (grid %d)\n", hipGetErrorString(e), grid);
#else
    for (int ph = 0; ph < NPH; ++ph) for (int rep = 0; rep < (ph == EXTRA_PHASE ? 2 : 1); ++rep) { a.ph_lo = ph; a.ph_hi = ph + 1; hipLaunchKernelGGL(mega_fwd, dim3(grid), dim3(512), LDS_BYTES, stream, a); }
#endif
}
```

```cpp
#include <hip/hip_runtime.h>
#include <hip/hip_cooperative_groups.h>
#include <cstdio>
#include <cstdint>
namespace cg = cooperative_groups;
namespace pg8 {
#define PG8_LAS __attribute__((address_space(3)))
typedef unsigned short bf16_t;
typedef short bf16x8 __attribute__((ext_vector_type(8)));
typedef float f32x4 __attribute__((ext_vector_type(4)));
typedef unsigned u32x4 __attribute__((ext_vector_type(4)));
constexpr int BM = 256, BK = 64, HALF = 128, HTB = HALF * BK * 2  , STAGE_BYTES = 8 * HTB, NXCD = 8, WGM = 8;

__host__ __device__ __forceinline__ int lds_byte(int r, int c) { const int st = (r >> 4) * 2 + (c >> 5), rr = r & 15, cc = c & 31, ob = rr * 64 + cc * 2; return st * 1024 + (ob ^ (((ob >> 9) & 1) << 5)); }
__host__ __device__ __forceinline__ void stage_rc(int b, int& R, int& C) { const int st = b / 1024, sb = b % 1024, swz = sb ^ (((sb >> 9) & 1) << 5); R = (st >> 1) * 16 + swz / 64; C = (st & 1) * 32 + (swz % 64) / 2; }
__host__ __device__ __forceinline__ int perm32(int rho) { const int n = rho >> 4, i = rho & 15; return 8 * (i >> 2) + 4 * n + (i & 3); }

struct Unit { int pm, pn; };
struct Gemm { const bf16_t* A; const bf16_t* Bt; int M, N, K; };

struct StaticOrder {
    int nM, nN, nwg, G, c;
    __host__ __device__ void init(int M, int N, int G_, int c_) { nM = M / BM; nN = N / BM; nwg = nM * nN; G = G_; c = c_; }
    __host__ __device__ bool next(int i, Unit& u) const {
        const long L = (long)i * G + c; if (L >= nwg) return false;
        int wgid = (int)L; { const int q = nwg / NXCD, r = nwg % NXCD, xcd = wgid % NXCD, off = wgid / NXCD; wgid = (xcd < r ? xcd * (q + 1) : r * (q + 1) + (xcd - r) * q) + off; }
        const int nig = WGM * nN, gid = wgid / nig, fm = gid * WGM, gsz = (nM - fm) < WGM ? (nM - fm) : WGM;
        u.pm = fm + ((wgid % nig) % gsz); u.pn = (wgid % nig) / gsz; return true;
    }
    __device__ __forceinline__ void a_ready(const Unit&) const {}
    __device__ __forceinline__ void done(const Unit&) const {}
};

typedef unsigned u32x2 __attribute__((ext_vector_type(2)));
typedef float f32x2v __attribute__((ext_vector_type(2)));
typedef __bf16 bf16x2v __attribute__((ext_vector_type(2)));
__device__ __forceinline__ unsigned pkbf(float lo, float hi) { f32x2v v = {lo, hi}; bf16x2v b = __builtin_convertvector(v, bf16x2v); return __builtin_bit_cast(unsigned, b); }
__device__ __forceinline__ float bflo(unsigned w) { return __uint_as_float(w << 16); }
__device__ __forceinline__ float bfhi(unsigned w) { return __uint_as_float(w & 0xffff0000u); }
__device__ __forceinline__ float sigm(float x) { return __builtin_amdgcn_rcpf(1.f + __builtin_amdgcn_exp2f(-1.4426950408889634f * x)); }
constexpr float RMS_EPS = 1e-6f;

struct EpiInProj {
    static constexpr bool PERM = true, AFTER_DRAIN = false;
    bf16_t* Qf; bf16_t* Kf; bf16_t* MISC; float qscale;
    __device__ __forceinline__ void operator()(const f32x4 (&acc)[2][2][4][2], const Unit& u, int wr, int wc, int fr, int fq) const {
        const int colt = u.pn * BM, row0 = u.pm * BM + wr * 64 + fr;
#pragma unroll
        for (int ai = 0; ai < 2; ++ai)
#pragma unroll
            for (int m = 0; m < 4; ++m) { const int row = row0 + ai * HALF + m * 16;
#pragma unroll
                for (int bj = 0; bj < 2; ++bj) { const int col = colt + bj * HALF + wc * 32 + 8 * fq;
                    f32x4 v0 = acc[ai][bj][m][0], v1 = acc[ai][bj][m][1]; bf16_t* dst;
                    if (colt < 2048) {
                        if (colt < 1024) { v0 = v0 * qscale; v1 = v1 * qscale; }
                        const int c = col & 1023, h = c >> 7, mp = (c >> 6) & 1, d = c & 63, d0 = d >> 4, hi = (d >> 3) & 1, b = row >> 11, s = row & 2047;
                        const size_t idx16 = (size_t)((((((b * 8 + h) * 2 + mp) * 64 + (s >> 5)) * 4 + d0) * 2 + hi)) * 32 + (s & 31);
                        dst = (colt < 1024 ? Qf : Kf) + idx16 * 8;
                    } else {
                        const int cc = col - 2048;
                        if (cc >= 2048) {
#pragma unroll
                            for (int i = 0; i < 4; ++i) { v0[i] = sigm(v0[i]); v1[i] = sigm(v1[i]); } }
                        dst = MISC + (size_t)row * 7168 + cc;
                    }
                    u32x4 w; w.x = pkbf(v0[0], v0[1]); w.y = pkbf(v0[2], v0[3]); w.z = pkbf(v1[0], v1[1]); w.w = pkbf(v1[2], v1[3]);
                    *(u32x4*)dst = w; } }
    }
};
struct EpiVT {
    static constexpr bool PERM = true, AFTER_DRAIN = false;
    bf16_t* VtF; bf16_t* MvT;
    __device__ __forceinline__ void operator()(const f32x4 (&acc)[2][2][4][2], const Unit& u, int wr, int wc, int fr, int fq) const {
        const int row0 = u.pm * BM + wr * 64 + fr;
#pragma unroll
        for (int ai = 0; ai < 2; ++ai)
#pragma unroll
            for (int m = 0; m < 4; ++m) { const int R = row0 + ai * HALF + m * 16;
#pragma unroll
                for (int bj = 0; bj < 2; ++bj) { const int tok0 = u.pn * BM + bj * HALF + wc * 32 + 8 * fq;
                    const f32x4 v0 = acc[ai][bj][m][0], v1 = acc[ai][bj][m][1];
                    if (u.pm < 4) {
                        const int h = R >> 7, e = R & 127, eb = e >> 5, e32 = e & 31, b = tok0 >> 11, s = tok0 & 2047, kt = s >> 5, g = (s & 31) >> 3, t = g >> 1, jb = 4 * (g & 1);
                        bf16_t* base = VtF + (size_t)(((((b * 8 + h) * 64 + kt) * 4 + eb) * 2 + t)) * 512 + e32 * 8 + jb;
                        u32x2 w0, w1; w0.x = pkbf(v0[0], v0[1]); w0.y = pkbf(v0[2], v0[3]); w1.x = pkbf(v1[0], v1[1]); w1.y = pkbf(v1[2], v1[3]);
                        *(u32x2*)base = w0; *(u32x2*)(base + 256) = w1;
                    } else {
                        u32x4 w; w.x = pkbf(v0[0], v0[1]); w.y = pkbf(v0[2], v0[3]); w.z = pkbf(v1[0], v1[1]); w.w = pkbf(v1[2], v1[3]);
                        *(u32x4*)(MvT + (size_t)(R - 1024) * 16384 + tok0) = w;
                    } } }
    }
};
struct EpiMerge {
    static constexpr bool PERM = true, AFTER_DRAIN = false;
    bf16_t* O; const bf16_t* G; int second;
    __device__ __forceinline__ void operator()(const f32x4 (&acc)[2][2][4][2], const Unit& u, int wr, int wc, int fr, int fq) const {
        const int row0 = u.pm * BM + wr * 64 + fr;
#pragma unroll
        for (int ai = 0; ai < 2; ++ai)
#pragma unroll
            for (int m = 0; m < 4; ++m) { const int row = row0 + ai * HALF + m * 16;
#pragma unroll
                for (int bj = 0; bj < 2; ++bj) { const int col = u.pn * BM + bj * HALF + wc * 32 + 8 * fq;
                    f32x4 v0 = acc[ai][bj][m][0], v1 = acc[ai][bj][m][1];
                    const u32x4 g = *(const u32x4*)(G + (size_t)row * 7168 + col);
                    v0[0] *= bflo(g.x); v0[1] *= bfhi(g.x); v0[2] *= bflo(g.y); v0[3] *= bfhi(g.y); v1[0] *= bflo(g.z); v1[1] *= bfhi(g.z); v1[2] *= bflo(g.w); v1[3] *= bfhi(g.w);
                    bf16_t* dst = O + (size_t)row * 2048 + col;
                    if (second) { const u32x4 p = *(const u32x4*)dst;
                        v0[0] += bflo(p.x); v0[1] += bfhi(p.x); v0[2] += bflo(p.y); v0[3] += bfhi(p.y); v1[0] += bflo(p.z); v1[1] += bfhi(p.z); v1[2] += bflo(p.w); v1[3] += bfhi(p.w); }
                    u32x4 w; w.x = pkbf(v0[0], v0[1]); w.y = pkbf(v0[2], v0[3]); w.z = pkbf(v1[0], v1[1]); w.w = pkbf(v1[2], v1[3]);
                    *(u32x4*)dst = w; } }
    }
};
struct EpiUp {
    static constexpr bool PERM = true, AFTER_DRAIN = false;
    bf16_t* O; const float* ssq;
    __device__ __forceinline__ void operator()(const f32x4 (&acc)[2][2][4][2], const Unit& u, int wr, int wc, int fr, int fq) const {
        const int row0 = u.pm * BM + wr * 64 + fr;
#pragma unroll
        for (int ai = 0; ai < 2; ++ai)
#pragma unroll
            for (int m = 0; m < 4; ++m) { const int row = row0 + ai * HALF + m * 16; const float rs = __builtin_amdgcn_rsqf(ssq[row] * (1.f / 2048.f) + RMS_EPS);
#pragma unroll
                for (int bj = 0; bj < 2; ++bj) { const int col = u.pn * BM + bj * HALF + wc * 32 + 8 * fq;
                    f32x4 v0 = acc[ai][bj][m][0] * rs, v1 = acc[ai][bj][m][1] * rs;
#pragma unroll
                    for (int i = 0; i < 4; ++i) { const float a = fmaxf(v0[i], 0.f), b = fmaxf(v1[i], 0.f); v0[i] = a * a; v1[i] = b * b; }
                    u32x4 w; w.x = pkbf(v0[0], v0[1]); w.y = pkbf(v0[2], v0[3]); w.z = pkbf(v1[0], v1[1]); w.w = pkbf(v1[2], v1[3]);
                    *(u32x4*)(O + (size_t)row * 8192 + col) = w; } }
    }
};
struct EpiGate {
    static constexpr bool PERM = true, AFTER_DRAIN = false;
    bf16_t* O; const float* ssq;
    __device__ __forceinline__ void operator()(const f32x4 (&acc)[2][2][4][2], const Unit& u, int wr, int wc, int fr, int fq) const {
        const int row0 = u.pm * BM + wr * 64 + fr;
#pragma unroll
        for (int ai = 0; ai < 2; ++ai)
#pragma unroll
            for (int m = 0; m < 4; ++m) { const int row = row0 + ai * HALF + m * 16; const float rs = __builtin_amdgcn_rsqf(ssq[row] * (1.f / 2048.f) + RMS_EPS);
#pragma unroll
                for (int bj = 0; bj < 2; ++bj) { const int col = u.pn * BM + bj * HALF + wc * 32 + 8 * fq;
                    f32x4 v0 = acc[ai][bj][m][0] * rs, v1 = acc[ai][bj][m][1] * rs;
#pragma unroll
                    for (int i = 0; i < 4; ++i) { v0[i] = sigm(v0[i]); v1[i] = sigm(v1[i]); }
                    u32x4 w; w.x = pkbf(v0[0], v0[1]); w.y = pkbf(v0[2], v0[3]); w.z = pkbf(v1[0], v1[1]); w.w = pkbf(v1[2], v1[3]);
                    *(u32x4*)(O + (size_t)row * 2048 + col) = w; } }
    }
};

struct EpiResB {
    static constexpr bool PERM = true, AFTER_DRAIN = false;
    const float* basef; const bf16_t* baseb; bf16_t* outb; float* ssq;
    __device__ __forceinline__ void operator()(const f32x4 (&acc)[2][2][4][2], const Unit& u, int wr, int wc, int fr, int fq) const {
        const int row0 = u.pm * BM + wr * 64 + fr;
#pragma unroll
        for (int ai = 0; ai < 2; ++ai)
#pragma unroll
            for (int m = 0; m < 4; ++m) { const int row = row0 + ai * HALF + m * 16; float s = 0.f;
#pragma unroll
                for (int bj = 0; bj < 2; ++bj) { const size_t c = (size_t)row * 2048 + u.pn * BM + bj * HALF + wc * 32 + 8 * fq;
                    f32x4 v0 = acc[ai][bj][m][0], v1 = acc[ai][bj][m][1];
                    if (basef) { v0 += *(const f32x4*)(basef + c); v1 += *(const f32x4*)(basef + c + 4); }
                    else { const u32x4 b = *(const u32x4*)(baseb + c);
                        v0[0] += bflo(b.x); v0[1] += bfhi(b.x); v0[2] += bflo(b.y); v0[3] += bfhi(b.y); v1[0] += bflo(b.z); v1[1] += bfhi(b.z); v1[2] += bflo(b.w); v1[3] += bfhi(b.w); }
                    s += ((v0[0] * v0[0] + v0[1] * v0[1]) + (v0[2] * v0[2] + v0[3] * v0[3])) + ((v1[0] * v1[0] + v1[1] * v1[1]) + (v1[2] * v1[2] + v1[3] * v1[3]));
                    u32x4 w; w.x = pkbf(v0[0], v0[1]); w.y = pkbf(v0[2], v0[3]); w.z = pkbf(v1[0], v1[1]); w.w = pkbf(v1[2], v1[3]);
                    *(u32x4*)(outb + c) = w; }
                s += __shfl_xor(s, 16); s += __shfl_xor(s, 32);
                if (fq == 0) atomicAdd(ssq + row, s);
                asm volatile("" ::: "memory"); }
    }
};
struct EpiPle3 {
    static constexpr bool PERM = true, AFTER_DRAIN = false;
    bf16_t* xb; const bf16_t* g; float* ssq_out;
    __device__ __forceinline__ void operator()(const f32x4 (&acc)[2][2][4][2], const Unit& u, int wr, int wc, int fr, int fq) const {
        const int row0 = u.pm * BM + wr * 64 + fr;
#pragma unroll
        for (int ai = 0; ai < 2; ++ai)
#pragma unroll
            for (int m = 0; m < 4; ++m) { const int row = row0 + ai * HALF + m * 16; float s = 0.f;
#pragma unroll
                for (int bj = 0; bj < 2; ++bj) { const size_t c = (size_t)row * 2048 + u.pn * BM + bj * HALF + wc * 32 + 8 * fq;
                    const f32x4 a0 = acc[ai][bj][m][0], a1 = acc[ai][bj][m][1]; const u32x4 b = *(const u32x4*)(xb + c), gw = *(const u32x4*)(g + c);
                    f32x4 v0, v1;
                    v0[0] = bflo(b.x) + bflo(gw.x) * a0[0]; v0[1] = bfhi(b.x) + bfhi(gw.x) * a0[1]; v0[2] = bflo(b.y) + bflo(gw.y) * a0[2]; v0[3] = bfhi(b.y) + bfhi(gw.y) * a0[3];
                    v1[0] = bflo(b.z) + bflo(gw.z) * a1[0]; v1[1] = bfhi(b.z) + bfhi(gw.z) * a1[1]; v1[2] = bflo(b.w) + bflo(gw.w) * a1[2]; v1[3] = bfhi(b.w) + bfhi(gw.w) * a1[3];
                    s += ((v0[0] * v0[0] + v0[1] * v0[1]) + (v0[2] * v0[2] + v0[3] * v0[3])) + ((v1[0] * v1[0] + v1[1] * v1[1]) + (v1[2] * v1[2] + v1[3] * v1[3]));
                    u32x4 w; w.x = pkbf(v0[0], v0[1]); w.y = pkbf(v0[2], v0[3]); w.z = pkbf(v1[0], v1[1]); w.w = pkbf(v1[2], v1[3]);
                    *(u32x4*)(xb + c) = w; }
                s += __shfl_xor(s, 16); s += __shfl_xor(s, 32);
                if (fq == 0) atomicAdd(ssq_out + row, s);
                asm volatile("" ::: "memory"); }
    }
};


template <class Epi, class Sched, bool ALIGN_EPI = false, bool SP2 = false>
__device__ __forceinline__ void gemm_phase(PG8_LAS unsigned char* lds, const Gemm g, const Sched& S, const Epi& E) {
    const int tid = threadIdx.x, wid = __builtin_amdgcn_readfirstlane(tid >> 6), lane = tid & 63, wr = wid >> 2, wc = wid & 3, fr = lane & 15, fq = lane >> 4;
    const int K = g.K, nt = K / BK;
    unsigned voffA[2], voffB[2];
#pragma unroll
    for (int i = 0; i < 2; ++i) { int R, C; stage_rc(tid * 16 + i * 8192, R, C); const int Rb = Epi::PERM ? ((R & ~31) + perm32(R & 31)) : R;
        voffA[i] = (unsigned)(R * K + C) * 2u; voffB[i] = (unsigned)(Rb * K + C) * 2u; }
    const size_t kstep = (size_t)(BK * 2);
    const size_t hstep = (size_t)HALF * K * 2;
    const size_t tstep = 2 * hstep;
    const unsigned ldsw = (unsigned)wid * 1024u;
    const int aoff = lds_byte(wr * 64 + fr, fq * 8), boff = lds_byte(wc * 32 + fr, fq * 8);
#define PG8_SA(b, h) (((b) * 2 + (h)) * HTB)
#define PG8_SB(b, h) ((4 + (b) * 2 + (h)) * HTB)
#define PG8_STAGE(bufoff, gbase, voff) do { _Pragma("unroll") for (int _i = 0; _i < 2; ++_i) \
        __builtin_amdgcn_global_load_lds((const unsigned*)((const char*)(gbase) + (voff)[_i]), (PG8_LAS unsigned*)(lds + (bufoff) + ldsw + _i * 8192), 16, 0, 0); } while (0)
#define PG8_LDA(dst, b, h) do { _Pragma("unroll") for (int m = 0; m < 4; ++m) _Pragma("unroll") for (int k = 0; k < 2; ++k) dst[m][k] = *(const PG8_LAS bf16x8*)(lds + PG8_SA(b, h) + aoff + m * 2048 + k * 1024); } while (0)
#define PG8_LDB(dst, b, h) do { _Pragma("unroll") for (int n = 0; n < 2; ++n) _Pragma("unroll") for (int k = 0; k < 2; ++k) dst[n][k] = *(const PG8_LAS bf16x8*)(lds + PG8_SB(b, h) + boff + n * 2048 + k * 1024); } while (0)
#define PG8_MMA(ai, bj, At, Bt) do { __builtin_amdgcn_s_setprio(1); _Pragma("unroll") for (int m = 0; m < 4; ++m) _Pragma("unroll") for (int n = 0; n < 2; ++n) _Pragma("unroll") for (int k = 0; k < 2; ++k) \
        acc[ai][bj][m][n] = __builtin_amdgcn_mfma_f32_16x16x32_bf16(Bt[n][k], At[m][k], acc[ai][bj][m][n], 0, 0, 0); __builtin_amdgcn_s_setprio(0); } while (0)
#define PG8_WAIT_V(n) asm volatile("s_waitcnt vmcnt(" #n ")" ::: "memory")
#define PG8_WAIT_L(n) asm volatile("s_waitcnt lgkmcnt(" #n ")" ::: "memory")
#define PG8_BAR __builtin_amdgcn_s_barrier()
#define PG8_SCHED __builtin_amdgcn_sched_barrier(0)
    Unit cur, nxt; int ui = 0;
    if (!S.next(0, cur)) return;
    f32x4 acc[2][2][4][2];
#pragma unroll
    for (int a = 0; a < 2; ++a)
#pragma unroll
        for (int b = 0; b < 2; ++b)
#pragma unroll
            for (int m = 0; m < 4; ++m)
#pragma unroll
                for (int n = 0; n < 2; ++n) acc[a][b][m][n] = (f32x4){0.f, 0.f, 0.f, 0.f};
    bf16x8 At[4][2], B0[2][2], B1[2][2];
    const char* cA = (const char*)g.A + (size_t)cur.pm * tstep; const char* cB = (const char*)g.Bt + (size_t)cur.pn * tstep;
    S.a_ready(cur);
    if constexpr (SP2) {
        PG8_STAGE(PG8_SB(0, 0), cB, voffB); PG8_STAGE(PG8_SB(0, 1), cB + hstep, voffB); PG8_STAGE(PG8_SA(0, 0), cA, voffA); PG8_STAGE(PG8_SA(0, 1), cA + hstep, voffA);
        if (wr == 1) PG8_BAR;
        PG8_WAIT_V(2); PG8_BAR;
        PG8_STAGE(PG8_SB(1, 0), cB + kstep, voffB); PG8_STAGE(PG8_SA(1, 0), cA + kstep, voffA); PG8_STAGE(PG8_SB(1, 1), cB + hstep + kstep, voffB);
        PG8_WAIT_V(6); PG8_BAR;
    } else {
        PG8_STAGE(PG8_SB(0, 0), cB, voffB); PG8_STAGE(PG8_SA(0, 0), cA, voffA); PG8_STAGE(PG8_SB(0, 1), cB + hstep, voffB); PG8_STAGE(PG8_SA(0, 1), cA + hstep, voffA);
        if (wr == 1) PG8_BAR;
        PG8_WAIT_V(4); PG8_BAR;
        PG8_STAGE(PG8_SB(1, 0), cB + kstep, voffB); PG8_STAGE(PG8_SA(1, 0), cA + kstep, voffA); PG8_STAGE(PG8_SB(1, 1), cB + hstep + kstep, voffB);
        PG8_WAIT_V(6); PG8_BAR;
    }
    for (;;) {
        const bool has_next = S.next(ui + 1, nxt);
        const char* nA = has_next ? (const char*)g.A + (size_t)nxt.pm * tstep : cA; const char* nB = has_next ? (const char*)g.Bt + (size_t)nxt.pn * tstep : cB;
        for (int t = 0; t < nt; t += 2) {
            const bool last = (t == nt - 2);
            const char* a1 = cA + (size_t)(t + 1) * kstep;
            const char* a2 = last ? nA : cA + (size_t)(t + 2) * kstep; const char* b2 = last ? nB : cB + (size_t)(t + 2) * kstep;
            const char* a3 = a2 + kstep; const char* b3 = b2 + kstep;
            if (last && has_next) S.a_ready(nxt);
            if constexpr (SP2) {
            PG8_LDB(B0, 0, 0); PG8_LDB(B1, 0, 1); PG8_SCHED; PG8_LDA(At, 0, 0); PG8_STAGE(PG8_SA(1, 1), a1 + hstep, voffA);
            PG8_WAIT_V(8); PG8_WAIT_L(0); PG8_BAR; PG8_MMA(0, 0, At, B0); PG8_MMA(0, 1, At, B1); PG8_BAR; PG8_SCHED;
            PG8_LDA(At, 0, 1); PG8_STAGE(PG8_SB(0, 0), b2, voffB); PG8_STAGE(PG8_SB(0, 1), b2 + hstep, voffB); PG8_STAGE(PG8_SA(0, 0), a2, voffA);
            PG8_WAIT_V(8); PG8_WAIT_L(0); PG8_BAR; PG8_MMA(1, 0, At, B0); PG8_MMA(1, 1, At, B1); PG8_BAR; PG8_SCHED;
            PG8_LDB(B0, 1, 0); PG8_LDB(B1, 1, 1); PG8_SCHED; PG8_LDA(At, 1, 0); PG8_STAGE(PG8_SA(0, 1), a2 + hstep, voffA);
            PG8_WAIT_V(8); PG8_WAIT_L(0); PG8_BAR; PG8_MMA(0, 0, At, B0); PG8_MMA(0, 1, At, B1); PG8_BAR; PG8_SCHED;
            PG8_LDA(At, 1, 1); PG8_STAGE(PG8_SB(1, 0), b3, voffB); PG8_STAGE(PG8_SB(1, 1), b3 + hstep, voffB); PG8_STAGE(PG8_SA(1, 0), a3, voffA);
            PG8_WAIT_V(8); PG8_WAIT_L(0); PG8_BAR; PG8_MMA(1, 0, At, B0); PG8_MMA(1, 1, At, B1); PG8_BAR; PG8_SCHED;
            } else {
            PG8_LDB(B0, 0, 0); PG8_SCHED; PG8_LDA(At, 0, 0); PG8_STAGE(PG8_SA(1, 1), a1 + hstep, voffA);
            PG8_WAIT_L(8); PG8_BAR; PG8_WAIT_L(0); PG8_MMA(0, 0, At, B0); PG8_BAR; PG8_SCHED;
            PG8_LDB(B1, 0, 1); PG8_STAGE(PG8_SB(0, 0), b2, voffB);
            PG8_BAR; PG8_WAIT_L(0); PG8_MMA(0, 1, At, B1); PG8_BAR;
            PG8_LDA(At, 0, 1); PG8_STAGE(PG8_SA(0, 0), a2, voffA);
            PG8_BAR; PG8_WAIT_L(0); PG8_MMA(1, 0, At, B0); PG8_BAR; PG8_SCHED;
            PG8_STAGE(PG8_SB(0, 1), b2 + hstep, voffB);
            PG8_WAIT_V(6); PG8_BAR; PG8_MMA(1, 1, At, B1); PG8_BAR;
            PG8_LDB(B0, 1, 0); PG8_SCHED; PG8_LDA(At, 1, 0); PG8_STAGE(PG8_SA(0, 1), a2 + hstep, voffA);
            PG8_WAIT_L(8); PG8_BAR; PG8_WAIT_L(0); PG8_MMA(0, 0, At, B0); PG8_BAR; PG8_SCHED;
            PG8_LDB(B1, 1, 1); PG8_STAGE(PG8_SB(1, 0), b3, voffB);
            PG8_BAR; PG8_WAIT_L(0); PG8_MMA(0, 1, At, B1); PG8_BAR;
            PG8_LDA(At, 1, 1); PG8_STAGE(PG8_SA(1, 0), a3, voffA);
            PG8_BAR; PG8_WAIT_L(0); PG8_MMA(1, 0, At, B0); PG8_BAR; PG8_SCHED;
            PG8_STAGE(PG8_SB(1, 1), b3 + hstep, voffB);
            PG8_WAIT_V(6); PG8_BAR; PG8_MMA(1, 1, At, B1); PG8_BAR;
            }
        }
        if constexpr (ALIGN_EPI) { if (wr == 0) PG8_BAR; }
        if constexpr (!Epi::AFTER_DRAIN) { E(acc, cur, wr, wc, fr, fq); S.done(cur); }
        if (!has_next) break;
#pragma unroll
        for (int a = 0; a < 2; ++a)
#pragma unroll
            for (int b = 0; b < 2; ++b)
#pragma unroll
                for (int m = 0; m < 4; ++m)
#pragma unroll
                    for (int n = 0; n < 2; ++n) acc[a][b][m][n] = (f32x4){0.f, 0.f, 0.f, 0.f};
        cur = nxt; cA = nA; cB = nB; ++ui;
        if constexpr (ALIGN_EPI) { if (wr == 1) PG8_BAR; }
    }
    PG8_WAIT_V(0);
    if constexpr (!ALIGN_EPI) { if (wr == 0) PG8_BAR; }
    PG8_BAR;
    if constexpr (Epi::AFTER_DRAIN) { E.fused(acc, cur, wr, wc, fr, fq, lds, wid, lane); S.done(cur); }
#undef PG8_SA
#undef PG8_SB
#undef PG8_STAGE
#undef PG8_LDA
#undef PG8_LDB
#undef PG8_MMA
#undef PG8_WAIT_V
#undef PG8_WAIT_L
#undef PG8_BAR
#undef PG8_SCHED
}
}

#ifndef PG8_SP2
#define PG8_SP2 true
#endif
#ifndef PG8_ALIGN
#define PG8_ALIGN true
#endif
#ifndef REPEAT_PHASE
#define REPEAT_PHASE -1
#endif
#define NREP(k) ((k) == REPEAT_PHASE ? 2 : 1)
#ifndef EXTRA_PHASE
#define EXTRA_PHASE -1
#endif
#ifndef PG8_ALIGN_HEAVY
#define PG8_ALIGN_HEAVY true
#endif
#ifndef MK_N_LAUNCHES
#define MK_N_LAUNCHES 1
#endif
#define LAS __attribute__((address_space(3)))
using pg8::bf16_t; using pg8::bf16x8; using pg8::f32x4; using pg8::u32x4; using pg8::u32x2; using pg8::pkbf; using pg8::bflo; using pg8::bfhi; using pg8::sigm; using pg8::RMS_EPS;
typedef float f32x16 __attribute__((ext_vector_type(16)));
#define MFMA32(a, b, c) __builtin_amdgcn_mfma_f32_32x32x16_bf16((a), (b), (c), 0, 0, 0)
#define MFMA16(a, b, c) __builtin_amdgcn_mfma_f32_16x16x32_bf16((a), (b), (c), 0, 0, 0)

constexpr int T = 16384, DM = 2048, DFF = 8192, INC = 11272, NPH = 11;
constexpr size_t MiB = (size_t)1 << 20;
constexpr size_t WS_MISC = 0, WS_QF = 224 * MiB, WS_KF = 256 * MiB, WS_VTF = 288 * MiB, WS_MVT = 320 * MiB, WS_MERGED = 352 * MiB;
constexpr size_t WS_WIN = 416 * MiB, WS_WVT = 452 * MiB, WS_WPA = 460 * MiB, WS_WPB = 464 * MiB, WS_WO = 468 * MiB, WS_WPG = 476 * MiB, WS_WPP = 484 * MiB, WS_PB = 485 * MiB;
constexpr size_t WS_GATES = 493 * MiB, WS_SS = 494 * MiB, WS_CTL = 496 * MiB, CTL_BYTES = 16384, WS_END = 497 * MiB;
constexpr int LDS_XB = 147392;
constexpr size_t WS_ACT = 0, WS_PP = 0, WS_XB = 256 * MiB, WS_WUP = 320 * MiB, WS_WDOWN = 416 * MiB;
constexpr size_t DO_H = 0, DO_YA = 0, DO_YB = 32 * MiB, DO_HRAW = 64 * MiB, DO_KCT = 96 * MiB;
constexpr size_t WS_QC = 352 * MiB, WS_KC = 384 * MiB;
constexpr int LDS_BYTES = 147456;

__device__ __forceinline__ float wave_sum(float v) {
#pragma unroll
    for (int o = 1; o < 64; o <<= 1) v += __shfl_xor(v, o);
    return v;
}
#define LDS_WAIT() asm volatile("s_waitcnt lgkmcnt(0)" ::: "memory")

__device__ __forceinline__ void transpose_item(const float* W, int ldw, int K, int srccol, const float* gain, bf16_t* WT, int n0, int k0, LAS float* scr, int lane) {
#pragma unroll 8
    for (int i = 0; i < 32; ++i) { const int kk = 2 * i + (lane >> 5); float v = W[(size_t)(k0 + kk) * ldw + srccol + (lane & 31)]; if (gain) v *= gain[k0 + kk]; scr[kk * 33 + (lane & 31)] = v; }
    LDS_WAIT();
    const int c = lane & 7;
#pragma unroll
    for (int j = 0; j < 4; ++j) { const int n = (lane >> 3) + 8 * j; const LAS float* s = scr + (8 * c) * 33 + n;
        u32x4 o; o.x = pkbf(s[0 * 33], s[1 * 33]); o.y = pkbf(s[2 * 33], s[3 * 33]); o.z = pkbf(s[4 * 33], s[5 * 33]); o.w = pkbf(s[6 * 33], s[7 * 33]);
        *(u32x4*)(WT + (size_t)(n0 + n) * K + k0 + 8 * c) = o; }
    LDS_WAIT();
}
__device__ __forceinline__ void transpose_job(const float* W, int ldw, int K, int N, const float* gain, bf16_t* WT, int mode, LAS float* scr, int gw, int NGW, int lane) {
    const int nblk = N / 32, items = (K / 64) * nblk;
    for (int it = gw; it < items; it += NGW) {
        const int kb = it / nblk, nb = it % nblk, n0 = 32 * nb;
        int src = n0;
        if (mode == 1) src = n0 < 2048 ? n0 : (n0 < 4096 ? n0 + 1024 : (n0 < 5120 ? n0 + 2048 : n0 + 2056));
        if (mode == 2) src = n0 < 1024 ? n0 + 2048 : n0 + 4096;
        transpose_item(W, ldw, K, src, gain, WT, n0, 64 * kb, scr, lane);
    }
}

__device__ __forceinline__ void attn_block_unit2(LAS unsigned char* lds, const bf16_t* __restrict__ Qf, const bf16_t* __restrict__ Kf, const bf16_t* __restrict__ VtF, bf16_t* __restrict__ ya, const float* __restrict__ subg, float lam,
                                                 int bh, int j, int tid, int wid, int lane) {
    const int r32 = lane & 31, hi = lane >> 5, qg = 8 * j + wid, nst = 4 * j + 4, myst = 4 * j + (wid >> 1) + 1;
    const int foff = hi * 512 + r32 * 16;
    LAS unsigned* park = (LAS unsigned*)(lds + 49152 + wid * 8192) + lane;
    const bf16_t* gv = VtF + (size_t)(bh * 64) * 4096 + tid * 8;
    f32x16 o[4];
#pragma unroll 1
    for (int mp = 0; mp < 2; ++mp) {
        bf16x8 q[4];
#pragma unroll
        for (int d0 = 0; d0 < 4; ++d0) q[d0] = *(const bf16x8*)(Qf + ((size_t)(((((bh * 2 + mp) * 64 + qg) * 4 + d0) * 2 + hi)) * 32 + r32) * 8);
        const bf16_t* gk = Kf + (size_t)((bh * 2 + mp) * 64) * 2048 + tid * 8;
        o[0] = f32x16{}; o[1] = f32x16{}; o[2] = f32x16{}; o[3] = f32x16{};
        float mrun = -INFINITY, lrun = 0.f;
        u32x4 pk = *(const u32x4*)gk, pv0 = *(const u32x4*)gv, pv1 = *(const u32x4*)(gv + 4096);
        *(LAS u32x4*)(lds + tid * 16) = pk; *(LAS u32x4*)(lds + 8192 + tid * 16) = pv0; *(LAS u32x4*)(lds + 16384 + tid * 16) = pv1;
        __syncthreads();
        for (int st = 0; st < nst; ++st) {
            LAS unsigned char* buf = lds + (st & 1) * 24576; LAS unsigned char* nbuf = lds + ((st + 1) & 1) * 24576;
            if (st + 1 < nst) { pk = *(const u32x4*)(gk + (size_t)(st + 1) * 4096); pv0 = *(const u32x4*)(gv + (size_t)(st + 1) * 8192); pv1 = *(const u32x4*)(gv + (size_t)(st + 1) * 8192 + 4096); }
            if (st < myst) {
#pragma unroll
                for (int u = 0; u < 2; ++u) {
                    f32x16 sc = {};
#pragma unroll
                    for (int d0 = 0; d0 < 4; ++d0) { const bf16x8 kf = *(const LAS bf16x8*)(buf + u * 4096 + d0 * 1024 + foff); sc = MFMA32(kf, q[d0], sc); }
                    float t = sc[0];
#pragma unroll
                    for (int r = 1; r < 16; ++r) t = fmaxf(t, sc[r]);
                    t = fmaxf(t, __shfl_xor(t, 32));
                    const float n = fmaxf(mrun, t);
                    if (__any(t > mrun + 8.f)) { const float al = __builtin_amdgcn_exp2f(mrun - n); lrun *= al;
#pragma unroll
                        for (int eb = 0; eb < 4; ++eb)
#pragma unroll
                            for (int r = 0; r < 16; ++r) o[eb][r] *= al;
                        mrun = n; }
                    float p[16], e = 0.f;
#pragma unroll
                    for (int r = 0; r < 16; ++r) { p[r] = __builtin_amdgcn_exp2f(sc[r] - mrun); e += p[r]; }
                    lrun += e;
                    u32x4 w0, w1; w0.x = pkbf(p[0], p[1]); w0.y = pkbf(p[2], p[3]); w0.z = pkbf(p[4], p[5]); w0.w = pkbf(p[6], p[7]);
                    w1.x = pkbf(p[8], p[9]); w1.y = pkbf(p[10], p[11]); w1.z = pkbf(p[12], p[13]); w1.w = pkbf(p[14], p[15]);
                    const bf16x8 pf0 = __builtin_bit_cast(bf16x8, w0), pf1 = __builtin_bit_cast(bf16x8, w1);
#pragma unroll
                    for (int eb = 0; eb < 4; ++eb) { const bf16x8 v0 = *(const LAS bf16x8*)(buf + 8192 + u * 8192 + (eb * 2 + 0) * 1024 + foff), v1 = *(const LAS bf16x8*)(buf + 8192 + u * 8192 + (eb * 2 + 1) * 1024 + foff);
                        o[eb] = MFMA32(v0, pf0, o[eb]); o[eb] = MFMA32(v1, pf1, o[eb]); }
                }
            }
            if (st + 1 < nst) { *(LAS u32x4*)(nbuf + tid * 16) = pk; *(LAS u32x4*)(nbuf + 8192 + tid * 16) = pv0; *(LAS u32x4*)(nbuf + 16384 + tid * 16) = pv1; }
            __syncthreads();
        }
        lrun += __shfl_xor(lrun, 32);
        if (mp == 0) { const float il = 1.f / lrun;
#pragma unroll
            for (int eb = 0; eb < 4; ++eb)
#pragma unroll
                for (int r = 0; r < 16; r += 2) park[(eb * 8 + (r >> 1)) * 64] = pkbf(o[eb][r] * il, o[eb][r + 1] * il);
        } else { const float c2 = -lam / lrun;
#pragma unroll
            for (int eb = 0; eb < 4; ++eb)
#pragma unroll
                for (int r = 0; r < 16; r += 2) { const unsigned w = park[(eb * 8 + (r >> 1)) * 64]; o[eb][r] = bflo(w) + c2 * o[eb][r]; o[eb][r + 1] = bfhi(w) + c2 * o[eb][r + 1]; }
        }
    }
    float ss = 0.f;
#pragma unroll
    for (int eb = 0; eb < 4; ++eb)
#pragma unroll
        for (int r = 0; r < 16; ++r) ss += o[eb][r] * o[eb][r];
    ss += __shfl_xor(ss, 32);
    const float rn = __builtin_amdgcn_rsqf(ss * (1.f / 128.f) + RMS_EPS) * 0.8f;
    const int b = bh >> 3, h = bh & 7;
    bf16_t* dst = ya + (size_t)(b * 2048 + qg * 32 + r32) * 1024 + h * 128;
#pragma unroll
    for (int eb = 0; eb < 4; ++eb)
#pragma unroll
        for (int g = 0; g < 4; ++g) { const int e0 = 32 * eb + 8 * g + 4 * hi; const f32x4 gg = *(const f32x4*)(subg + e0);
            u32x2 w; w.x = pkbf(o[eb][4 * g] * rn * gg[0], o[eb][4 * g + 1] * rn * gg[1]); w.y = pkbf(o[eb][4 * g + 2] * rn * gg[2], o[eb][4 * g + 3] * rn * gg[3]);
            *(u32x2*)(dst + e0) = w; }
}

__device__ __forceinline__ void conv_prepass2(LAS unsigned char* lds, const bf16_t* __restrict__ MISC_, const float* __restrict__ conv_w, const float* __restrict__ conv_b, bf16_t* __restrict__ QC_, bf16_t* __restrict__ KC_, bf16_t* __restrict__ KCT_,
                                              int blk, int nblk, int tid) {
    constexpr int TPK = 72;
    LAS bf16_t* tile = (LAS bf16_t*)lds;
    const int cpl = tid & 255, th = tid >> 8;
    for (int it = blk; it < 1024; it += nblk) {
        const int cg_ = it & 3, tb = it >> 2, ch = cg_ * 512 + 2 * cpl, trow0 = tb * 64 + th * 32; const bool isk = cg_ >= 2, seqstart = (trow0 & 2047) == 0;
        const bf16_t* src = MISC_ + (size_t)trow0 * 7168 + ch;
        float cw0[4], cw1[4];
#pragma unroll
        for (int j = 0; j < 4; ++j) { cw0[j] = conv_w[j * 2048 + ch]; cw1[j] = conv_w[j * 2048 + ch + 1]; }
        const float cb0 = conv_b[ch], cb1 = conv_b[ch + 1], osc = isk ? 1.f : 0.0625f;
        bf16_t* dst = (isk ? KC_ : QC_) + (size_t)trow0 * 1024 + (ch & 1023);
        float xa[3], xb[3];
#pragma unroll
        for (int j = 0; j < 3; ++j) { unsigned w = 0u; if (!seqstart) w = *(const unsigned*)(src - (size_t)(3 - j) * 7168); xa[j] = bflo(w); xb[j] = bfhi(w); }
#pragma unroll
        for (int g = 0; g < 4; ++g) {
            float ya_[8], yb_[8];
#pragma unroll
            for (int i = 0; i < 8; ++i) { const int tt = g * 8 + i;
                const unsigned w = *(const unsigned*)(src + (size_t)tt * 7168); const float x0 = bflo(w), x1 = bfhi(w);
                float y0 = cb0 + cw0[0] * xa[0] + cw0[1] * xa[1] + cw0[2] * xa[2] + cw0[3] * x0;
                float y1 = cb1 + cw1[0] * xb[0] + cw1[1] * xb[1] + cw1[2] * xb[2] + cw1[3] * x1;
                xa[0] = xa[1]; xa[1] = xa[2]; xa[2] = x0; xb[0] = xb[1]; xb[1] = xb[2]; xb[2] = x1;
                y0 = y0 * sigm(y0) * osc; y1 = y1 * sigm(y1) * osc; ya_[i] = y0; yb_[i] = y1;
                *(unsigned*)(dst + (size_t)tt * 1024) = pkbf(y0, y1); }
            if (isk) {
                u32x4 wa, wb; wa.x = pkbf(ya_[0], ya_[1]); wa.y = pkbf(ya_[2], ya_[3]); wa.z = pkbf(ya_[4], ya_[5]); wa.w = pkbf(ya_[6], ya_[7]);
                wb.x = pkbf(yb_[0], yb_[1]); wb.y = pkbf(yb_[2], yb_[3]); wb.z = pkbf(yb_[4], yb_[5]); wb.w = pkbf(yb_[6], yb_[7]);
                *(LAS u32x4*)(tile + (2 * cpl) * TPK + th * 32 + g * 8) = wa; *(LAS u32x4*)(tile + (2 * cpl + 1) * TPK + th * 32 + g * 8) = wb; }
        }
        if (isk) {
            __syncthreads();
#pragma unroll
            for (int i = 0; i < 8; ++i) { const int idx = tid + 512 * i, row = idx >> 3, seg = idx & 7;
                *(u32x4*)(KCT_ + (size_t)((cg_ - 2) * 512 + row) * 16384 + tb * 64 + 8 * seg) = *(const LAS u32x4*)(tile + row * TPK + 8 * seg); }
            __syncthreads();
        }
    }
}

__device__ __forceinline__ void mlstm_unit(LAS unsigned char* lds, const bf16_t* __restrict__ QC, const bf16_t* __restrict__ KC, const bf16_t* __restrict__ KCT, const bf16_t* __restrict__ MvT, const float* __restrict__ gates,
                                           bf16_t* __restrict__ hraw, int b, int hh, int es, int tid, int wid, int lane) {
    constexpr int QP = 264, TP = 72;
    LAS bf16_t* qs = (LAS bf16_t*)(lds);
    LAS bf16_t* ks = (LAS bf16_t*)(lds + 33792);
    LAS bf16_t* kT = (LAS bf16_t*)(lds + 67584);
    LAS bf16_t* Cb = (LAS bf16_t*)(lds + 104448);
    LAS bf16_t* Sb = (LAS bf16_t*)(lds + 121344);
    LAS float* nvec = (LAS float*)(lds + 130560);
    LAS float* aS = (LAS float*)(lds + 132608);
    LAS float* ML = aS + 64; LAS float* IW = aS + 128; LAS float* EM = aS + 192; LAS float* WS = aS + 256;
    LAS bf16_t* Vs = (LAS bf16_t*)(lds + 134144);
    LAS bf16_t* Vw = (LAS bf16_t*)(lds + 138752);
    LAS bf16_t* nb16 = (LAS bf16_t*)(lds + 143360);
    const int r32 = lane & 31, hi = lane >> 5, r16 = lane & 15, kq = lane >> 4, lt = wid >> 1, et = wid & 1;
    f32x16 C = {};
    if (tid < 256) { nvec[tid] = 0.f; nb16[tid] = 0; }
    float m_prev = 0.f;
    const bf16_t* qsrc = QC + (size_t)(b * 2048) * 1024 + hh * 256;
    const bf16_t* ksrc = KC + (size_t)(b * 2048) * 1024 + hh * 256;
    const bf16_t* ktsrc = KCT + (size_t)(hh * 256) * 16384 + b * 2048;
    const float* gsrc = gates + (size_t)(b * 2048 + lane) * 8 + hh;
    const bf16_t* vsrc = MvT + (size_t)(hh * 256 + es * 32 + (tid >> 4)) * 16384 + b * 2048 + 4 * (tid & 15);
    u32x4 pq[4], pk[4], pt[4]; float pli, plf; u32x2 pv;
#define ML_PREFETCH(cc) do { \
        _Pragma("unroll") for (int i = 0; i < 4; ++i) { const int idx = tid + 512 * i; \
            pq[i] = *(const u32x4*)(qsrc + (size_t)((cc) * 64 + (idx >> 5)) * 1024 + 8 * (idx & 31)); pk[i] = *(const u32x4*)(ksrc + (size_t)((cc) * 64 + (idx >> 5)) * 1024 + 8 * (idx & 31)); \
            } \
        pli = gsrc[(size_t)(cc) * 512]; plf = gsrc[(size_t)(cc) * 512 + 4]; } while (0)
#define ML_PREFETCH2(cc) do { \
        _Pragma("unroll") for (int i = 0; i < 4; ++i) { const int idx = tid + 512 * i; pt[i] = *(const u32x4*)(ktsrc + (size_t)(idx >> 3) * 16384 + (cc) * 64 + 8 * (idx & 7)); } \
        pv = *(const u32x2*)(vsrc + (cc) * 64); } while (0)
    ML_PREFETCH(0); ML_PREFETCH2(0);
    for (int c = 0; c < 32; ++c) {
        const int t0 = b * 2048 + c * 64;
        LAS float* nv_cur = nvec + (c & 1) * 256; LAS float* nv_nxt = nvec + ((c + 1) & 1) * 256;
        LAS bf16_t* nb_cur = nb16 + (c & 1) * 256; LAS bf16_t* nb_nxt = nb16 + ((c + 1) & 1) * 256;
        const float li = pli, lf = plf;
        float bc = lf;
#pragma unroll
        for (int o = 1; o < 64; o <<= 1) { const float v = __shfl_up(bc, o); if (lane >= o) bc += v; }
        const float a = li - bc; float A = a;
#pragma unroll
        for (int o = 1; o < 64; o <<= 1) { const float v = __shfl_up(A, o); if (lane >= o) A = fmaxf(A, v); }
        const float Mx = fmaxf(m_prev, A), iw = __expf(m_prev - Mx), em = __expf(-(bc + Mx));
        const float M63 = fmaxf(m_prev, __shfl(A, 63)), wsv = __expf(a - M63), decay = __expf(m_prev - M63), m_new = __shfl(bc, 63) + M63;
        if (wid == 0) { aS[lane] = a; ML[lane] = Mx; IW[lane] = iw; EM[lane] = em; WS[lane] = wsv; }
#pragma unroll
        for (int i = 0; i < 4; ++i) { const int idx = tid + 512 * i;
            *(LAS u32x4*)(qs + (idx >> 5) * QP + 8 * (idx & 31)) = pq[i]; *(LAS u32x4*)(ks + (idx >> 5) * QP + 8 * (idx & 31)) = pk[i]; *(LAS u32x4*)(kT + (idx >> 3) * TP + 8 * (idx & 7)) = pt[i]; }
        { const int sb = 4 * (tid & 15);
            *(LAS u32x2*)(Vs + (tid >> 4) * TP + sb) = pv;
            u32x2 sv; sv.x = pkbf(bflo(pv.x) * __shfl(wsv, sb), bfhi(pv.x) * __shfl(wsv, sb + 1)); sv.y = pkbf(bflo(pv.y) * __shfl(wsv, sb + 2), bfhi(pv.y) * __shfl(wsv, sb + 3));
            *(LAS u32x2*)(Vw + (tid >> 4) * TP + sb) = sv; }
        if (c + 1 < 32) ML_PREFETCH(c + 1);
        __syncthreads();
#pragma unroll
        for (int sti = 0; sti < 2; ++sti) { const int st = 2 * (wid & 1) + sti; f32x4 g4 = {0.f, 0.f, 0.f, 0.f};
            if (st <= lt) {
#pragma unroll
                for (int kb = 0; kb < 8; ++kb) { const bf16x8 af = *(const LAS bf16x8*)(qs + (16 * lt + r16) * QP + 32 * kb + 8 * kq), bf = *(const LAS bf16x8*)(ks + (16 * st + r16) * QP + 32 * kb + 8 * kq);
                    g4 = MFMA16(af, bf, g4); if (kb & 1) __builtin_amdgcn_sched_barrier(0); } }
            __builtin_amdgcn_sched_barrier(0);
            const int s = 16 * st + r16; const float as = aS[s];
#pragma unroll
            for (int r = 0; r < 4; ++r) { const int l = 16 * lt + 4 * kq + r; const float v = (s <= l) ? g4[r] * __expf(fminf(as - ML[l], 0.f)) : 0.f;
                Sb[l * TP + s] = (bf16_t)(pkbf(v, 0.f) & 0xffffu); } }
#pragma unroll
        for (int g = 0; g < 4; ++g) { u32x2 w; w.x = pkbf(C[4 * g], C[4 * g + 1]); w.y = pkbf(C[4 * g + 2], C[4 * g + 3]); *(LAS u32x2*)(Cb + r32 * QP + 32 * wid + 8 * g + 4 * hi) = w; }
        __syncthreads();
        f32x4 nm = {0.f, 0.f, 0.f, 0.f}, dn = {0.f, 0.f, 0.f, 0.f};
        const unsigned msk = (r16 == 0) ? 0xFFFFFFFFu : 0u;
#pragma unroll
        for (int kb = 0; kb < 8; ++kb) { const bf16x8 af = *(const LAS bf16x8*)(qs + (16 * lt + r16) * QP + 32 * kb + 8 * kq), bf = *(const LAS bf16x8*)(Cb + (16 * et + r16) * QP + 32 * kb + 8 * kq);
            u32x4 nw = *(const LAS u32x4*)(nb_cur + 32 * kb + 8 * kq); nw.x &= msk; nw.y &= msk; nw.z &= msk; nw.w &= msk; const bf16x8 nf = __builtin_bit_cast(bf16x8, nw);
            nm = MFMA16(af, bf, nm); dn = MFMA16(af, nf, dn); if (kb & 1) __builtin_amdgcn_sched_barrier(0); }
        __builtin_amdgcn_sched_barrier(0);
#pragma unroll
        for (int r = 0; r < 4; ++r) { const float w = IW[16 * lt + 4 * kq + r]; nm[r] *= w; dn[r] *= w; }
#pragma unroll
        for (int kb = 0; kb < 2; ++kb) { const bf16x8 af = *(const LAS bf16x8*)(Sb + (16 * lt + r16) * TP + 32 * kb + 8 * kq), bf = *(const LAS bf16x8*)(Vs + (16 * et + r16) * TP + 32 * kb + 8 * kq);
            u32x4 ow; ow.x = 0x3F803F80u & msk; ow.y = ow.x; ow.z = ow.x; ow.w = ow.x;
            nm = MFMA16(af, bf, nm); dn = MFMA16(af, __builtin_bit_cast(bf16x8, ow), dn); }
#pragma unroll
        for (int r = 0; r < 4; ++r) { const int l = 16 * lt + 4 * kq + r; const float dnv = fmaxf(fabsf(__shfl(dn[r], kq * 16)), EM[l]); const float hv = nm[r] / dnv;
            hraw[((size_t)((b * 4 + hh) * 8 + es) * 2048 + (c * 64 + l)) * 32 + 16 * et + r16] = (bf16_t)(pkbf(hv, 0.f) & 0xffffu); }
        if (c + 1 < 32) ML_PREFETCH2(c + 1);
#pragma unroll
        for (int i = 0; i < 16; ++i) C[i] *= decay;
#pragma unroll
        for (int kb = 0; kb < 4; ++kb) { const bf16x8 af = *(const LAS bf16x8*)(kT + (32 * wid + r32) * TP + 16 * kb + 8 * hi);
            const bf16x8 sv = *(const LAS bf16x8*)(Vw + r32 * TP + 16 * kb + 8 * hi);
            C = MFMA32(af, sv, C); __builtin_amdgcn_sched_barrier(0); }
        { const int d = tid >> 1, half = tid & 1; float sacc = 0.f;
#pragma unroll
            for (int i = 0; i < 4; ++i) { const u32x4 kw = *(const LAS u32x4*)(kT + d * TP + 32 * half + 8 * i); const f32x4 w0 = *(const LAS f32x4*)(WS + 32 * half + 8 * i), w1 = *(const LAS f32x4*)(WS + 32 * half + 8 * i + 4);
                sacc += bflo(kw.x) * w0[0] + bfhi(kw.x) * w0[1] + bflo(kw.y) * w0[2] + bfhi(kw.y) * w0[3] + bflo(kw.z) * w1[0] + bfhi(kw.z) * w1[1] + bflo(kw.w) * w1[2] + bfhi(kw.w) * w1[3];
                if (i & 1) __builtin_amdgcn_sched_barrier(0); }
            sacc += __shfl_xor(sacc, 1);
            if (half == 0) { const float nn = decay * nv_cur[d] + sacc; nv_nxt[d] = nn; nb_nxt[d] = (bf16_t)(pkbf(nn, 0.f) & 0xffffu); } }
        m_prev = m_new;
        __syncthreads();
    }
#undef ML_PREFETCH
#undef ML_PREFETCH2
}

#define XB_TMO      128
#define XB_XCNT(j)  (256  + 64 * (j))
#define XB_XSUB(j)  (1280 + 64 * (j))
#define XB_XGEN(j)  (2304 + 64 * (j))
#define XB_TOP      3328
#define XB_TOPGEN   3392
#define XCD_BAR_WORDS 3456
#define XB_SPIN_CAP (1u << 18)

__device__ __forceinline__ unsigned xb_ld(unsigned* p)              { return __hip_atomic_load(p, __ATOMIC_RELAXED, __HIP_MEMORY_SCOPE_AGENT); }
__device__ __forceinline__ unsigned xb_add(unsigned* p, unsigned v) { return __hip_atomic_fetch_add(p, v, __ATOMIC_RELAXED, __HIP_MEMORY_SCOPE_AGENT); }
__device__ __forceinline__ unsigned xb_xcc_id() { return (unsigned)__builtin_amdgcn_s_getreg((3 << 11) | 20) & 0xFu; }
#define XB_SPIN(cond, bar) do { unsigned _sp = 0; while (cond) { __builtin_amdgcn_s_sleep(1); \
    if ((++_sp & 255u) == 0u) { if (xb_ld(&(bar)[XB_TMO])) break; if (_sp > XB_SPIN_CAP) { atomicAdd(&(bar)[XB_TMO], 1u); break; } } } } while (0)

struct XcdBarrier {
    unsigned* bar; unsigned x;
    volatile LAS unsigned* st;
};

__device__ __forceinline__ XcdBarrier xcd_barrier_post(unsigned* bar, volatile LAS unsigned* st) {
    XcdBarrier b; b.bar = bar; b.x = xb_xcc_id(); b.st = st;
    if (threadIdx.x == 0) (void)xb_add(&bar[XB_XCNT(b.x)], 1u);
    return b;
}
__device__ __forceinline__ void xcd_barrier_complete(unsigned* bar, unsigned x, unsigned& nloc, unsigned& nx) {
    const unsigned G = gridDim.x * gridDim.y * gridDim.z;
    unsigned sum, cnt, mine, sp = 0u;
    for (;;) {
        sum = 0u; cnt = 0u; mine = 0u;
#pragma unroll
        for (unsigned j = 0; j < 16; ++j) { const unsigned c = xb_ld(&bar[XB_XCNT(j)]); sum += c; cnt += (c > 0u) ? 1u : 0u; mine = (j == x) ? c : mine; }
        if (sum == G) break;
        __builtin_amdgcn_s_sleep(1);
        if ((++sp & 255u) == 0u) { if (xb_ld(&bar[XB_TMO])) break; if (sp > XB_SPIN_CAP) { atomicAdd(&bar[XB_TMO], 1u); break; } }
    }
    nloc = mine > 0u ? mine : 1u; nx = cnt > 0u ? cnt : 1u;
}

__device__ __forceinline__ void xcd_barrier(const XcdBarrier& b) {
    asm volatile("s_waitcnt vmcnt(0)" ::: "memory");
    __syncthreads();
    if (threadIdx.x == 0) {
        unsigned* bar = b.bar;
        __builtin_amdgcn_s_waitcnt(0);
        unsigned nloc = b.st[0], nx = b.st[1];
        if (nloc == 0u) { xcd_barrier_complete(bar, b.x, nloc, nx); b.st[0] = nloc; b.st[1] = nx; }
        const unsigned old = xb_add(&bar[XB_XSUB(b.x)], 1u);
        const unsigned gen = old / nloc;
        if (old + 1u == (gen + 1u) * nloc) {
            __builtin_amdgcn_fence(__ATOMIC_RELEASE, "agent");
            asm volatile("s_waitcnt vmcnt(0)" ::: "memory");
            const unsigned og = xb_add(&bar[XB_TOP], 1u);
            const unsigned tg = og / nx;
            if (og + 1u == (tg + 1u) * nx) xb_add(&bar[XB_TOPGEN], 1u);
            else XB_SPIN(xb_ld(&bar[XB_TOPGEN]) == tg, bar);
            __builtin_amdgcn_fence(__ATOMIC_ACQUIRE, "agent");
            xb_add(&bar[XB_XGEN(b.x)], 1u);
            asm volatile("s_waitcnt vmcnt(0)" ::: "memory");
        } else {
            XB_SPIN(xb_ld(&bar[XB_XGEN(b.x)]) == gen, bar);
            __builtin_amdgcn_fence(__ATOMIC_ACQUIRE, "agent");
            asm volatile("s_waitcnt vmcnt(0)" ::: "memory");
        }
    }
    __syncthreads();
}

struct Args { const float* in[24]; float* out; unsigned char* ws; int ph_lo, ph_hi; };
enum { I_X = 0, I_P, I_GMIX, I_WIN, I_CONVW, I_CONVB, I_BI, I_BF, I_LQ1, I_LK1, I_LQ2, I_LK2, I_SUBG, I_MLG, I_WPA, I_WPB, I_WO, I_GMLP, I_WUP, I_WDOWN, I_GPLE, I_WPG, I_WPP, I_GFIN };

__global__ void __launch_bounds__(512, 2) mega_fwd(Args args) {
    extern __shared__ __attribute__((aligned(16))) unsigned char lds_raw[];
    LAS unsigned char* lds = (LAS unsigned char*)lds_raw;
    cg::grid_group grid = cg::this_grid();
    const int tid = threadIdx.x, lane = tid & 63, wid = __builtin_amdgcn_readfirstlane(tid >> 6);
    const int G = gridDim.x, gw = blockIdx.x * 8 + wid, NGW = G * 8;
    const int vblk = (G % 8 == 0) ? (int)(blockIdx.x % 8) * (G / 8) + (int)(blockIdx.x / 8) : (int)blockIdx.x;
    unsigned char* ws = args.ws; unsigned char* dob = (unsigned char*)args.out;
    const int lo = args.ph_lo, hi_ph = args.ph_hi;
#ifndef ONLY_PHASE
#define PH_EN(k) true
#else
#define PH_EN(k) ((k) == ONLY_PHASE)
#endif
#define IN(k) (PH_EN(k) && lo <= (k) && (k) < hi_ph)
#define SEAM(k) do { if (IN(k) && IN((k) + 1)) { if ((k) == 0) grid.sync(); else xcd_barrier(xbar); } } while (0)
    volatile LAS unsigned* xst = (volatile LAS unsigned*)(lds + LDS_XB);
    if (tid == 0) { xst[0] = 0u; xst[1] = 0u; }
    __syncthreads();
    XcdBarrier xbar; xbar.bar = (unsigned*)(ws + WS_CTL); xbar.x = 0; xbar.st = xst;
    if (hi_ph - lo > 1) xbar = xcd_barrier_post((unsigned*)(ws + WS_CTL), xst);
#define MISC ((bf16_t*)(ws + WS_MISC))
#define Qf ((bf16_t*)(ws + WS_QF))
#define Kf ((bf16_t*)(ws + WS_KF))
#define VtF ((bf16_t*)(ws + WS_VTF))
#define MvT ((bf16_t*)(ws + WS_MVT))
#define MERGED ((bf16_t*)(ws + WS_MERGED))
#define WIN ((bf16_t*)(ws + WS_WIN))
#define WVT ((bf16_t*)(ws + WS_WVT))
#define WPA ((bf16_t*)(ws + WS_WPA))
#define WPB ((bf16_t*)(ws + WS_WPB))
#define WO ((bf16_t*)(ws + WS_WO))
#define WPG ((bf16_t*)(ws + WS_WPG))
#define WPP ((bf16_t*)(ws + WS_WPP))
#define PB ((bf16_t*)(ws + WS_PB))
#define GATES ((float*)(ws + WS_GATES))
#define SS ((float*)(ws + WS_SS))
#define ACT ((bf16_t*)(ws + WS_ACT))
#define PP ((float*)(ws + WS_PP))
#define XB ((bf16_t*)(ws + WS_XB))
#define WUP ((bf16_t*)(ws + WS_WUP))
#define WDOWN ((bf16_t*)(ws + WS_WDOWN))
#define HB ((bf16_t*)(dob + DO_H))
#define YA ((bf16_t*)(dob + DO_YA))
#define YB ((bf16_t*)(dob + DO_YB))
#define HRAW ((bf16_t*)(dob + DO_HRAW))
#define KCT ((bf16_t*)(dob + DO_KCT))
#define QC ((bf16_t*)(ws + WS_QC))
#define KC ((bf16_t*)(ws + WS_KC))
    LAS float* scr = (LAS float*)(lds + wid * 8448);

    if (IN(0)) for (int rep = 0; rep < NREP(0); ++rep) {
        const float* w_in = args.in[I_WIN];
        transpose_job(w_in, INC, DM, 9216, nullptr, WIN, 1, scr, gw, NGW, lane);
        transpose_job(w_in, INC, DM, 2048, nullptr, WVT, 2, scr, gw, NGW, lane);
        transpose_job(args.in[I_WPA], DM, 1024, DM, nullptr, WPA, 0, scr, gw, NGW, lane);
        transpose_job(args.in[I_WPB], DM, 1024, DM, nullptr, WPB, 0, scr, gw, NGW, lane);
        transpose_job(args.in[I_WO], DM, DM, DM, nullptr, WO, 0, scr, gw, NGW, lane);
        transpose_job(args.in[I_WPG], DM, DM, DM, args.in[I_GPLE], WPG, 0, scr, gw, NGW, lane);
        transpose_job(args.in[I_WPP], DM, 256, DM, nullptr, WPP, 0, scr, gw, NGW, lane);
        { const float* p = args.in[I_P];
            for (size_t i = ((size_t)blockIdx.x * 512 + tid) * 8; i < (size_t)T * 256; i += (size_t)G * 512 * 8) { const f32x4 a = *(const f32x4*)(p + i), b = *(const f32x4*)(p + i + 4);
                u32x4 w; w.x = pkbf(a[0], a[1]); w.y = pkbf(a[2], a[3]); w.z = pkbf(b[0], b[1]); w.w = pkbf(b[2], b[3]); *(u32x4*)(PB + i) = w; }
            for (int i = blockIdx.x * 512 + tid; i < 3 * T; i += G * 512) SS[i] = 0.f; }
        __syncthreads();
        LAS float* tab = (LAS float*)lds;
        for (int idx = tid; idx < 2 * DM; idx += 512) { const int k = idx >> 1, half = idx & 1; const f32x4 v = *(const f32x4*)(w_in + (size_t)k * INC + 7168 + 4 * half);
#pragma unroll
            for (int i = 0; i < 4; ++i) tab[(4 * half + i) * DM + k] = v[i]; }
        __syncthreads();
        const float* x = args.in[I_X]; const float* gmix = args.in[I_GMIX];
        for (int row = gw; row < T; row += NGW) {
            const f32x4* xr = (const f32x4*)(x + (size_t)row * DM) + lane; f32x4 v[8]; float s = 0.f;
#pragma unroll
            for (int j = 0; j < 8; ++j) { v[j] = xr[64 * j]; s += (v[j][0] * v[j][0] + v[j][1] * v[j][1]) + (v[j][2] * v[j][2] + v[j][3] * v[j][3]); }
            const float rs = 1.0f / sqrtf(wave_sum(s) * (1.f / DM) + RMS_EPS);
#pragma unroll
            for (int j = 0; j < 8; ++j) { const f32x4 g4 = *((const f32x4*)gmix + lane + 64 * j); v[j] = v[j] * rs * g4;
                u32x2 w; w.x = pkbf(v[j][0], v[j][1]); w.y = pkbf(v[j][2], v[j][3]); *((u32x2*)(HB + (size_t)row * DM) + lane + 64 * j) = w; }
            float myg = 0.f;
#pragma unroll 1
            for (int jj = 0; jj < 8; ++jj) { float acc = 0.f;
#pragma unroll
                for (int j = 0; j < 8; ++j) { const f32x4 t4 = *((const LAS f32x4*)(tab + jj * DM) + lane + 64 * j); acc += (v[j][0] * t4[0] + v[j][1] * t4[1]) + (v[j][2] * t4[2] + v[j][3] * t4[3]); }
                acc = wave_sum(acc); if (lane == jj) myg = acc; }
            if (lane < 8) { float r;
                if (lane < 4) r = myg + args.in[I_BI][lane];
                else { const float z = myg + args.in[I_BF][lane - 4]; r = fminf(z, 0.f) - log1pf(__expf(-fabsf(z))); }
                GATES[(size_t)row * 8 + lane] = r; }
        }
        __syncthreads();
    }
    SEAM(0);
    if (IN(1)) for (int rep = 0; rep < NREP(1); ++rep) {
        { pg8::Gemm g{HB, WIN, T, 9216, DM}; pg8::StaticOrder S; S.init(T, 9216, G, (int)blockIdx.x);
          pg8::EpiInProj E{Qf, Kf, MISC, 0.125f * 1.4426950408889634f};
          pg8::gemm_phase<pg8::EpiInProj, pg8::StaticOrder, PG8_ALIGN, PG8_SP2>(lds, g, S, E); }
        { pg8::Gemm g{WVT, HB, 2048, T, DM}; pg8::StaticOrder S; S.init(2048, T, G, (int)blockIdx.x);
          pg8::EpiVT E{VtF, MvT};
          pg8::gemm_phase<pg8::EpiVT, pg8::StaticOrder, PG8_ALIGN, PG8_SP2>(lds, g, S, E); }
    }
    SEAM(1);
    if (IN(2)) {
        for (int rep = 0; rep < NREP(12); ++rep) transpose_job(args.in[I_WDOWN], DM, DFF, DM, nullptr, WDOWN, 0, scr, gw, NGW, lane);
        __syncthreads();
        for (int rep = 0; rep < NREP(2); ++rep) conv_prepass2(lds, MISC, args.in[I_CONVW], args.in[I_CONVB], QC, KC, KCT, (int)blockIdx.x, G, tid);
        __syncthreads();
    }
    SEAM(2);
    if (IN(3)) {
        for (int rep = 0; rep < NREP(3); ++rep)
        for (int u = vblk; u < 256; u += G)
            mlstm_unit(lds, QC, KC, KCT, MvT, GATES, HRAW, u >> 5, (u >> 3) & 3, u & 7, tid, wid, lane);
    }
    SEAM(3);
    if (IN(4)) {
        { const float* __restrict__ mlg = args.in[I_MLG]; const bf16_t* __restrict__ hr = HRAW; const bf16_t* __restrict__ mo = MISC + 2048; bf16_t* __restrict__ yb = YB;
          f32x4 g4[4];
#pragma unroll
          for (int hh = 0; hh < 4; ++hh) g4[hh] = *(const f32x4*)(mlg + hh * 256 + 4 * lane);
          for (int rp = gw; rp < T / 2; rp += NGW) {
            u32x2 hw[2][4], ow[2][4]; const int row = 2 * rp, row1 = 2 * rp + 1, bb = row >> 11, sq = row & 2047;
#pragma unroll
            for (int hh = 0; hh < 4; ++hh) { const int c0 = hh * 256 + 4 * lane; const size_t ho = ((size_t)((bb * 4 + hh) * 8 + (lane >> 3)) * 2048 + sq) * 32 + 4 * (lane & 7);
                hw[0][hh] = *(const u32x2*)(hr + ho); ow[0][hh] = *(const u32x2*)(mo + (size_t)row * 7168 + c0);
                hw[1][hh] = *(const u32x2*)(hr + ho + 32); ow[1][hh] = *(const u32x2*)(mo + (size_t)row1 * 7168 + c0); }
#pragma unroll
            for (int r = 0; r < 2; ++r) { const int rw = r ? row1 : row;
#pragma unroll
                for (int hh = 0; hh < 4; ++hh) { const int c0 = hh * 256 + 4 * lane;
                    const float h0 = bflo(hw[r][hh].x), h1 = bfhi(hw[r][hh].x), h2 = bflo(hw[r][hh].y), h3 = bfhi(hw[r][hh].y);
                    const float rn = 1.0f / sqrtf(wave_sum((h0 * h0 + h1 * h1) + (h2 * h2 + h3 * h3)) * (1.f / 256.f) + RMS_EPS);
                    u32x2 w; w.x = pkbf(h0 * rn * g4[hh][0] * bflo(ow[r][hh].x), h1 * rn * g4[hh][1] * bfhi(ow[r][hh].x)); w.y = pkbf(h2 * rn * g4[hh][2] * bflo(ow[r][hh].y), h3 * rn * g4[hh][3] * bfhi(ow[r][hh].y));
                    *(u32x2*)(yb + (size_t)rw * 1024 + c0) = w; } }
          } }
        float l1 = args.in[I_LQ1][lane] * args.in[I_LK1][lane], l2 = args.in[I_LQ2][lane] * args.in[I_LK2][lane];
        const float lam = expf(wave_sum(l1)) - expf(wave_sum(l2)) + 0.2f;
        __syncthreads();
        for (int rep = 0; rep < NREP(4); ++rep)
        for (int vb = vblk; vb < 256; vb += G) { const int bh = vb >> 2, pr = vb & 3;
            attn_block_unit2(lds, Qf, Kf, VtF, YA, args.in[I_SUBG], lam, bh, pr, tid, wid, lane);
            attn_block_unit2(lds, Qf, Kf, VtF, YA, args.in[I_SUBG], lam, bh, 7 - pr, tid, wid, lane); }
        __syncthreads();
    }
    SEAM(4);
    if (IN(5)) for (int rep = 0; rep < NREP(5); ++rep) {
        { pg8::Gemm g{YA, WPA, T, DM, 1024}; pg8::StaticOrder S; S.init(T, DM, G, (int)blockIdx.x);
          pg8::EpiMerge E{MERGED, MISC + 3072, 0};
          pg8::gemm_phase<pg8::EpiMerge, pg8::StaticOrder, PG8_ALIGN, PG8_SP2>(lds, g, S, E); }
        { pg8::Gemm g{YB, WPB, T, DM, 1024}; pg8::StaticOrder S; S.init(T, DM, G, (int)blockIdx.x);
          pg8::EpiMerge E{MERGED, MISC + 5120, 1};
          pg8::gemm_phase<pg8::EpiMerge, pg8::StaticOrder, PG8_ALIGN, PG8_SP2>(lds, g, S, E); }
    }
    SEAM(5);
    if (IN(6)) {
        transpose_job(args.in[I_WUP], DFF, DM, DFF, args.in[I_GMLP], WUP, 0, scr, gw, NGW, lane);
        __syncthreads();
        pg8::Gemm g{MERGED, WO, T, DM, DM}; pg8::StaticOrder S; S.init(T, DM, G, (int)blockIdx.x);
        pg8::EpiResB E{args.in[I_X], nullptr, XB, SS};
        pg8::gemm_phase<pg8::EpiResB, pg8::StaticOrder, PG8_ALIGN_HEAVY, PG8_SP2>(lds, g, S, E);
    }
    SEAM(6);
    if (IN(7)) for (int rep = 0; rep < NREP(7); ++rep) {
        pg8::Gemm g{XB, WUP, T, DFF, DM}; pg8::StaticOrder S; S.init(T, DFF, G, (int)blockIdx.x);
        pg8::EpiUp E{ACT, SS};
        pg8::gemm_phase<pg8::EpiUp, pg8::StaticOrder, PG8_ALIGN, PG8_SP2>(lds, g, S, E);
    }
    SEAM(7);
    if (IN(8)) {
        pg8::Gemm g{ACT, WDOWN, T, DM, DFF}; pg8::StaticOrder S; S.init(T, DM, G, (int)blockIdx.x);
        pg8::EpiResB E{nullptr, XB, XB, SS + T};
        pg8::gemm_phase<pg8::EpiResB, pg8::StaticOrder, PG8_ALIGN_HEAVY, PG8_SP2>(lds, g, S, E);
    }
    SEAM(8);
    if (IN(9)) {
        bf16_t* GB = (bf16_t*)(ws + WS_PP);
        { pg8::Gemm g{XB, WPG, T, DM, DM}; pg8::StaticOrder S; S.init(T, DM, G, (int)blockIdx.x);
          pg8::EpiGate E{GB, SS + T};
          pg8::gemm_phase<pg8::EpiGate, pg8::StaticOrder, PG8_ALIGN, PG8_SP2>(lds, g, S, E); }
        { int kpp = 256; asm volatile("" : "+s"(kpp)); pg8::Gemm g{PB, WPP, T, DM, kpp}; pg8::StaticOrder S; S.init(T, DM, G, (int)blockIdx.x);
          pg8::EpiPle3 E{XB, GB, SS + 2 * T};
          pg8::gemm_phase<pg8::EpiPle3, pg8::StaticOrder, PG8_ALIGN_HEAVY, PG8_SP2>(lds, g, S, E); }
    }
    SEAM(9);
    if (IN(10)) {
        const float* __restrict__ gfin = args.in[I_GFIN]; const bf16_t* __restrict__ xb = XB; float* __restrict__ outp = args.out;
        for (int row = gw; row < T; row += NGW) {
            const float rs = 1.0f / sqrtf(SS[2 * T + row] * (1.f / DM) + RMS_EPS);
            const u32x2* xr = (const u32x2*)(xb + (size_t)row * DM) + lane; f32x4* orow = (f32x4*)(outp + (size_t)row * DM) + lane;
#pragma unroll
            for (int j = 0; j < 8; ++j) { const u32x2 w = xr[64 * j]; const f32x4 g4 = *((const f32x4*)gfin + lane + 64 * j);
                f32x4 v; v[0] = bflo(w.x) * rs * g4[0]; v[1] = bfhi(w.x) * rs * g4[1]; v[2] = bflo(w.y) * rs * g4[2]; v[3] = bfhi(w.y) * rs * g4[3]; orow[64 * j] = v; }
        }
    }
#undef IN
#undef SEAM
#undef MISC
#undef Qf
#undef Kf
#undef VtF
#undef MvT
#undef MERGED
#undef WIN
#undef WVT
#undef WPA
#undef WPB
#undef WO
#undef WPG
#undef WPP
#undef PB
#undef GATES
#undef SS
#undef ACT
#undef PP
#undef XB
#undef WUP
#undef WDOWN
#undef HB
#undef YA
#undef YB
#undef HRAW
#undef KCT
#undef QC
#undef KC
}

extern "C" void kernel_launch(void* const* d_in, const int* in_sizes, int n_in, void* d_out, int out_size, void* d_ws, size_t ws_size, hipStream_t stream) {
    static int grid = 0;
    if (grid == 0) {
        if (n_in != 24 || out_size != T * DM || ws_size < WS_END) { fprintf(stderr, "kernel_launch: unexpected problem (n_in %d, out %d, ws %zu)\n", n_in, out_size, ws_size); grid = -1; return; }
        int dev = 0, cus = 0, per_cu = 0;
        if (hipGetDevice(&dev) != hipSuccess || hipDeviceGetAttribute(&cus, hipDeviceAttributeMultiprocessorCount, dev) != hipSuccess) { grid = -1; return; }
        if (hipFuncSetAttribute((const void*)mega_fwd, hipFuncAttributeMaxDynamicSharedMemorySize, LDS_BYTES) != hipSuccess) { fprintf(stderr, "kernel_launch: hipFuncSetAttribute failed\n"); grid = -1; return; }
        if (hipOccupancyMaxActiveBlocksPerMultiprocessor(&per_cu, (const void*)mega_fwd, 512, LDS_BYTES) != hipSuccess || per_cu < 1) { fprintf(stderr, "kernel_launch: occupancy query says %d\n", per_cu); (void)hipGetLastError(); grid = -1; return; }
        grid = cus;
    }
    if (grid < 0) return;
    if (hipMemsetAsync((char*)d_ws + WS_CTL, 0, CTL_BYTES, stream) != hipSuccess) { fprintf(stderr, "kernel_launch: hipMemsetAsync failed\n"); return; }
    Args a{};
    for (int i = 0; i < 24; ++i) a.in[i] = (const float*)d_in[i];
    a.out = (float*)d_out; a.ws = (unsigned char*)d_ws;
#if MK_N_LAUNCHES == 1
    a.ph_lo = 0; a.ph_hi = NPH;
    void* kargs[] = {&a};
    hipError_t e = hipLaunchCooperativeKernel((const void*)mega_fwd, dim3(grid), dim3(512), kargs, LDS_BYTES, stream);
    if (e != hipSuccess) fprintf(stderr, "kernel_launch: cooperative launch failed: %s (grid %d)\n", hipGetErrorString(e), grid);
#else
    for (int ph = 0; ph < NPH; ++ph) for (int rep = 0; rep < (ph == EXTRA_PHASE ? 2 : 1); ++rep) { a.ph_lo = ph; a.ph_hi = ph + 1; hipLaunchKernelGGL(mega_fwd, dim3(grid), dim3(512), LDS_BYTES, stream, a); }
#endif
}
```
